# Optimizing an MI355X kernel written in HIP

```python
import jax, jax.numpy as jnp
from jax import lax
import numpy as np

D_MODEL = 2048
BATCH = 1
SEQ = 8192
DEPTH = 4

CHUNK = 64
N_A_LAYERS = DEPTH // 2
N_B_LAYERS = DEPTH - N_A_LAYERS
RWKV_HEAD = 64
RWKV_HEADS = D_MODEL // RWKV_HEAD
DECAY_LORA = 96
AAA_LORA = 96
MV_LORA = 64
GATE_LORA = 256
N_MIX = 6
LNX_EPS = 1e-5 * RWKV_HEAD
FOX_HEAD = 128
FOX_HEADS = D_MODEL // FOX_HEAD
Q_BLOCK = 128
D_FF = 4 * D_MODEL
RMS_EPS = 1e-6

kernel_name = "rwkv7_fox_yoco_hybrid"


def rms_norm(x, gain):
    xf = x.astype(jnp.float32)
    y = xf * lax.rsqrt(jnp.mean(xf * xf, axis=-1, keepdims=True) + RMS_EPS)
    return (y * gain.astype(jnp.float32)).astype(x.dtype)


def squared_relu_mlp(h, w_up, w_down):
    return jnp.square(jax.nn.relu(h @ w_up)) @ w_down


def rwkv7_recurrence(r, decay, k, v, a, b):
    B, S, H, N = r.shape
    n_chunks = S // CHUNK

    def to_chunks(t):
        return t.reshape(B, n_chunks, CHUNK, H, N).transpose(1, 2, 0, 3, 4)

    def step(state, inp):
        r_t, w_t, k_t, v_t, a_t, b_t = inp
        sa = jnp.einsum('bhvk,bhk->bhv', state, a_t)
        state = (state * w_t[:, :, None, :]
                 + sa[..., None] * b_t[:, :, None, :]
                 + v_t[..., None] * k_t[:, :, None, :])
        y_t = jnp.einsum('bhvk,bhk->bhv', state, r_t)
        return state, y_t

    def chunk_step(state, chunk_inp):
        return lax.scan(step, state, chunk_inp)

    state0 = jnp.zeros((B, H, N, N), jnp.float32)
    inputs = (to_chunks(r), to_chunks(decay), to_chunks(k), to_chunks(v), to_chunks(a), to_chunks(b))
    _, y = lax.scan(chunk_step, state0, inputs)
    return y.transpose(2, 0, 1, 3, 4).reshape(B, S, H, N)


def rwkv7_time_mix(h, x_mix, w_rkv, w0, w1, w2, a0, a1, a2, g1, g2, k_k, k_a, r_k,
                   lnx_w, lnx_b, w_o, v_first, v_res):
    B, S, D = h.shape
    H, N = RWKV_HEADS, RWKV_HEAD
    f32 = jnp.float32
    prev = jnp.pad(h, ((0, 0), (1, 0), (0, 0)))[:, :S]
    xs = h[:, :, None, :] + (prev - h)[:, :, None, :] * x_mix
    rkv = jnp.einsum('bsnd,nde->bsne', xs[:, :, :3], w_rkv)
    r, k, v = rkv[:, :, 0], rkv[:, :, 1], rkv[:, :, 2]
    xv, xw, xa, xg = xs[:, :, 2], xs[:, :, 3], xs[:, :, 4], xs[:, :, 5]

    w_log = -jax.nn.softplus(-(w0 + jnp.tanh(xw @ w1) @ w2).astype(f32)) - 0.5
    decay = jnp.exp(-jnp.exp(w_log))
    if v_res is None:
        v_first = v
    else:
        v0, v1, v2 = v_res
        v = v + (v_first - v) * jax.nn.sigmoid(v0 + (xv @ v1) @ v2)
    a = jax.nn.sigmoid((a0 + (xa @ a1) @ a2).astype(f32))
    g = jax.nn.sigmoid(xg @ g1) @ g2

    heads = lambda t: t.astype(f32).reshape(B, S, H, N)
    kk = heads(k * k_k)
    kk = kk / jnp.maximum(jnp.sqrt(jnp.sum(kk * kk, axis=-1, keepdims=True)), 1e-12)
    k = k.astype(f32) * (1.0 + (a - 1.0) * k_a.astype(f32))
    rh, kh, vh, ah, dh = heads(r), heads(k), heads(v), heads(a), heads(decay)

    y = rwkv7_recurrence(rh, dh, kh, vh, -kk, kk * ah)
    mu = jnp.mean(y, axis=-1, keepdims=True)
    var = jnp.mean(jnp.square(y - mu), axis=-1, keepdims=True)
    y = ((y - mu) * lax.rsqrt(var + LNX_EPS)).reshape(B, S, D)
    y = y * lnx_w.astype(f32) + lnx_b.astype(f32)
    bonus = jnp.sum(rh * kh * r_k.astype(f32), axis=-1, keepdims=True) * vh
    y = y + bonus.reshape(B, S, D)
    out = (y * g.astype(f32)).astype(w_o.dtype) @ w_o
    return out.astype(h.dtype), v_first


def shared_kv_forget(x, kv_norm, w_kvf, b_f):
    B, S, D = x.shape
    proj = rms_norm(x, kv_norm) @ w_kvf
    k = proj[..., :D].reshape(B, S, FOX_HEADS, FOX_HEAD).transpose(0, 2, 1, 3)
    v = proj[..., D:2 * D].reshape(B, S, FOX_HEADS, FOX_HEAD).transpose(0, 2, 1, 3)
    log_f = jax.nn.log_sigmoid((proj[..., 2 * D:] + b_f).astype(jnp.float32))
    cum_log_f = jnp.cumsum(log_f.transpose(0, 2, 1), axis=-1)
    return k, v, cum_log_f


def forgetting_attention(h, w_q, w_o, k, v, cum_log_f):
    B, S, D = h.shape
    q = (h @ w_q).reshape(B, S, FOX_HEADS, FOX_HEAD).transpose(0, 2, 1, 3)
    scale = FOX_HEAD ** -0.5
    outs = []
    for blk in range(S // Q_BLOCK):
        q0, q1 = blk * Q_BLOCK, (blk + 1) * Q_BLOCK
        kb, vb = k[:, :, :q1], v[:, :, :q1]
        s = jnp.einsum('bhqd,bhkd->bhqk', q[:, :, q0:q1], kb).astype(jnp.float32) * scale
        s = s + cum_log_f[:, :, q0:q1, None] - cum_log_f[:, :, None, :q1]
        causal = jnp.arange(q0, q1)[:, None] >= jnp.arange(q1)[None, :]
        p = jax.nn.softmax(jnp.where(causal, s, -jnp.inf), axis=-1)
        outs.append(jnp.einsum('bhqk,bhkd->bhqd', p.astype(vb.dtype), vb))
    o = jnp.concatenate(outs, axis=2).transpose(0, 2, 1, 3).reshape(B, S, D)
    return o @ w_o


def setup_inputs(seed: int = 0) -> dict:
    key = jax.random.key(seed)
    ks = iter(jax.random.split(key, 40))
    D = D_MODEL
    nrm = lambda shape, scale: jax.random.normal(next(ks), shape, jnp.float32) * scale
    unif = lambda shape, lo, hi: jax.random.uniform(next(ks), shape, jnp.float32, lo, hi)
    na, nb = N_A_LAYERS, N_B_LAYERS
    return {
        "x": nrm((BATCH, SEQ, D), 1.0),
        "mix_norm": 1.0 + nrm((DEPTH, D), 0.02),
        "ffn_norm": 1.0 + nrm((DEPTH, D), 0.02),
        "final_norm": 1.0 + nrm((D,), 0.02),
        "rwkv_x_mix": unif((na, N_MIX, D), 0.0, 1.0),
        "rwkv_w_rkv": nrm((na, 3, D, D), D ** -0.5),
        "rwkv_w0": unif((na, D), -6.0, -1.0),
        "rwkv_w1": nrm((na, D, DECAY_LORA), D ** -0.5),
        "rwkv_w2": nrm((na, DECAY_LORA, D), 0.5 * DECAY_LORA ** -0.5),
        "rwkv_a0": nrm((na, D), 0.1),
        "rwkv_a1": nrm((na, D, AAA_LORA), D ** -0.5),
        "rwkv_a2": nrm((na, AAA_LORA, D), AAA_LORA ** -0.5),
        "rwkv_v0": nrm((na - 1, D), 0.1),
        "rwkv_v1": nrm((na - 1, D, MV_LORA), D ** -0.5),
        "rwkv_v2": nrm((na - 1, MV_LORA, D), MV_LORA ** -0.5),
        "rwkv_g1": nrm((na, D, GATE_LORA), D ** -0.5),
        "rwkv_g2": nrm((na, GATE_LORA, D), GATE_LORA ** -0.5),
        "rwkv_k_k": 0.85 + nrm((na, D), 0.02),
        "rwkv_k_a": 1.0 + nrm((na, D), 0.02),
        "rwkv_r_k": nrm((na, RWKV_HEADS, RWKV_HEAD), 0.1),
        "rwkv_lnx_w": 1.0 + nrm((na, D), 0.02),
        "rwkv_lnx_b": nrm((na, D), 0.02),
        "rwkv_w_o": nrm((na, D, D), D ** -0.5),
        "kv_norm": 1.0 + nrm((D,), 0.02),
        "w_kvf": nrm((D, 2 * D + FOX_HEADS), D ** -0.5),
        "b_f": nrm((FOX_HEADS,), 0.1),
        "fox_w_q": nrm((nb, D, D), D ** -0.5),
        "fox_w_o": nrm((nb, D, D), D ** -0.5),
        "mlp_w_up": nrm((DEPTH, D, D_FF), D ** -0.5),
        "mlp_w_down": nrm((DEPTH, D_FF, D), D_FF ** -0.5),
    }


def reference(x, mix_norm, ffn_norm, final_norm, rwkv_x_mix, rwkv_w_rkv, rwkv_w0, rwkv_w1,
              rwkv_w2, rwkv_a0, rwkv_a1, rwkv_a2, rwkv_v0, rwkv_v1, rwkv_v2, rwkv_g1, rwkv_g2,
              rwkv_k_k, rwkv_k_a, rwkv_r_k, rwkv_lnx_w, rwkv_lnx_b, rwkv_w_o, kv_norm, w_kvf,
              b_f, fox_w_q, fox_w_o, mlp_w_up, mlp_w_down):
    v_first = None
    k_sh = v_sh = c_sh = None
    for layer in range(DEPTH):
        if layer < N_A_LAYERS:
            i = layer
            v_res = None if i == 0 else (rwkv_v0[i - 1], rwkv_v1[i - 1], rwkv_v2[i - 1])
            h = rms_norm(x, mix_norm[layer])
            mixed, v_first = rwkv7_time_mix(
                h, rwkv_x_mix[i], rwkv_w_rkv[i], rwkv_w0[i], rwkv_w1[i], rwkv_w2[i],
                rwkv_a0[i], rwkv_a1[i], rwkv_a2[i], rwkv_g1[i], rwkv_g2[i], rwkv_k_k[i],
                rwkv_k_a[i], rwkv_r_k[i], rwkv_lnx_w[i], rwkv_lnx_b[i], rwkv_w_o[i],
                v_first, v_res)
        else:
            if layer == N_A_LAYERS:
                k_sh, v_sh, c_sh = shared_kv_forget(x, kv_norm, w_kvf, b_f)
            j = layer - N_A_LAYERS
            h = rms_norm(x, mix_norm[layer])
            mixed = forgetting_attention(h, fox_w_q[j], fox_w_o[j], k_sh, v_sh, c_sh)
        x = x + mixed
        x = x + squared_relu_mlp(rms_norm(x, ffn_norm[layer]), mlp_w_up[layer], mlp_w_down[layer])
    return rms_norm(x, final_norm)
```

```cpp
#include <hip/hip_runtime.h>
#include <cstdio>
#include <cstdint>

#define LAS __attribute__((address_space(3)))
#define GAS __attribute__((address_space(1)))
typedef unsigned short bf16_t;
typedef short bf16x8 __attribute__((ext_vector_type(8)));
typedef short bf16x4 __attribute__((ext_vector_type(4)));
typedef float f32x4 __attribute__((ext_vector_type(4)));
typedef float f32x16 __attribute__((ext_vector_type(16)));
typedef unsigned u32x4 __attribute__((ext_vector_type(4)));
typedef unsigned u32x2 __attribute__((ext_vector_type(2)));

#ifndef MK_SPLIT
#define MK_SPLIT 0
#endif

constexpr int S = 8192, D = 2048, FF = 8192, NLAYER = 4;
constexpr int RH = 32, RN = 64;
constexpr int FH = 16, FD = 128;
constexpr int LORA_N = 512;
constexpr int KVF_LD = 2 * D + FH;
constexpr float RMS_EPS = 1e-6f;
constexpr float LNX_EPS = 1e-5f * RN;
constexpr float LOG2E = 1.4426950408889634f;
constexpr float QK_SCALE = 0.35709584f;

constexpr size_t MiB = (size_t)1 << 20;
constexpr size_t WS_CTL = 0, CTL_ZERO_BYTES = 1 * MiB;
constexpr size_t WS_WRKV = 1 * MiB;
constexpr size_t WS_WLD = 49 * MiB;
constexpr size_t WS_WLU = 57 * MiB;
constexpr size_t WS_WWO = 65 * MiB;
constexpr size_t WS_WUP01 = 81 * MiB;
constexpr size_t WS_WDN01 = 145 * MiB;
constexpr size_t WS_WQK = 1 * MiB;
constexpr size_t WS_WV = 17 * MiB;
constexpr size_t WS_WFO = 25 * MiB;
constexpr size_t WS_WQ3 = 65 * MiB;
constexpr size_t WS_WUP2 = 81 * MiB;
constexpr size_t WS_WDN2 = 145 * MiB;
constexpr size_t WS_WUP3 = 738 * MiB;
constexpr size_t WS_WDN3 = 930 * MiB;
constexpr size_t WS_CW = 209 * MiB;
constexpr size_t WS_CBH = 241 * MiB;
constexpr size_t WS_CR = 273 * MiB;
constexpr size_t WS_CARB = 305 * MiB;
constexpr size_t WS_CU0 = 337 * MiB;
constexpr size_t WS_CKV = 369 * MiB;
constexpr size_t WS_CY0 = 433 * MiB;
constexpr size_t WS_CGC = 497 * MiB;
constexpr size_t WS_BS = 499 * MiB;
constexpr size_t WS_H = 385 * MiB;
constexpr size_t WS_XS = 418 * MiB;
constexpr size_t WS_R = 514 * MiB;
constexpr size_t WS_K = 578 * MiB;
constexpr size_t WS_V = 642 * MiB;
constexpr size_t WS_VF = 706 * MiB;
constexpr size_t WS_PART = 770 * MiB;
constexpr size_t WS_WLDEC = 834 * MiB;
constexpr size_t WS_A = 898 * MiB;
constexpr size_t WS_G = 962 * MiB;
constexpr size_t WS_END = 994 * MiB;
constexpr size_t WS_Q = WS_WLDEC, WS_KB = WS_WLDEC + 32 * MiB, WS_VT = WS_A, WS_O = WS_G;
constexpr size_t WS_LF = WS_PART, WS_CS = WS_PART + 1 * MiB;
constexpr size_t WS_U = WS_R;
constexpr size_t WS_HF = 674 * MiB;
constexpr size_t WS_YG = WS_R, WS_ACT = WS_XS + 64 * MiB;
constexpr size_t WS_CUT = WS_PART, WS_CS0 = WS_PART + 32 * MiB;
constexpr int CW_SS = 16384;
constexpr int CW_BAR = 4096;
constexpr int CW_WAMAX = 8448;
#ifndef F8_M3_MASK
#define F8_M3_MASK 0xC
#endif

constexpr int RING_BYTES = 131072;
constexpr int MISC_OFF = 163840 - 64;
constexpr int LDS_BYTES = 163840;

typedef __bf16 bf16x2_t __attribute__((ext_vector_type(2)));
typedef float f32x2_t __attribute__((ext_vector_type(2)));
typedef _Float16 f16x2_t __attribute__((ext_vector_type(2)));
__device__ __forceinline__ unsigned cvt_pk_f16(float lo, float hi) { const f32x2_t f = {lo, hi}; const f16x2_t h = __builtin_convertvector(f, f16x2_t); return __builtin_bit_cast(unsigned, h); }
typedef int i32x4 __attribute__((ext_vector_type(4)));
typedef int i32x8 __attribute__((ext_vector_type(8)));
__device__ __forceinline__ unsigned cvt_pk_bf16(float lo, float hi) { const f32x2_t f = {lo, hi}; const bf16x2_t b = __builtin_convertvector(f, bf16x2_t); return __builtin_bit_cast(unsigned, b); }

__device__ __forceinline__ unsigned pk_fp8x4(float a, float b, float c, float d) {
    a = fminf(fmaxf(a, -448.f), 448.f); b = fminf(fmaxf(b, -448.f), 448.f); c = fminf(fmaxf(c, -448.f), 448.f); d = fminf(fmaxf(d, -448.f), 448.f);
    int r = __builtin_amdgcn_cvt_pk_fp8_f32(a, b, 0, false); r = __builtin_amdgcn_cvt_pk_fp8_f32(c, d, r, true); return (unsigned)r;
}
__device__ __forceinline__ float w8_scale(unsigned amax_bits) { unsigned e = (amax_bits >> 23) & 0xffu; e = e < 8u ? 8u : (e > 250u ? 250u : e); return __builtin_bit_cast(float, (260u - e) << 23); }
__device__ __forceinline__ float w8_inv_scale(unsigned amax_bits) { unsigned e = (amax_bits >> 23) & 0xffu; e = e < 8u ? 8u : (e > 250u ? 250u : e); return __builtin_bit_cast(float, (e - 6u) << 23); }
constexpr float U8_SCALE = 8.0f;
__device__ __forceinline__ float wave_sum(float v) {
#pragma unroll
    for (int o = 1; o < 64; o <<= 1) v += __shfl_xor(v, o);
    return v;
}
__device__ __forceinline__ float sigmoidf_(float x) { return 1.0f / (1.0f + __expf(-x)); }
__device__ __forceinline__ float softplusf_(float z) { return fmaxf(z, 0.f) + __logf(1.0f + __expf(-fabsf(z))); }

#define XB_TMO      128
#define XB_XCNT(j)  (256  + 64 * (j))
#define XB_XSUB(j)  (1280 + 64 * (j))
#define XB_XGEN(j)  (2304 + 64 * (j))
#define XB_TOP      3328
#define XB_TOPGEN   3392
#define XCD_BAR_WORDS 3456
#define XB_SPIN_CAP (1u << 18)

__device__ __forceinline__ unsigned xb_ld(unsigned* p)              { return __hip_atomic_load(p, __ATOMIC_RELAXED, __HIP_MEMORY_SCOPE_AGENT); }
__device__ __forceinline__ unsigned xb_add(unsigned* p, unsigned v) { return __hip_atomic_fetch_add(p, v, __ATOMIC_RELAXED, __HIP_MEMORY_SCOPE_AGENT); }
__device__ __forceinline__ unsigned xb_xcc_id() { return (unsigned)__builtin_amdgcn_s_getreg((3 << 11) | 20) & 0xFu; }
#define XB_SPIN(cond, bar) do { unsigned _sp = 0; while (cond) { __builtin_amdgcn_s_sleep(1); \
    if ((++_sp & 255u) == 0u) { if (xb_ld(&(bar)[XB_TMO])) break; if (_sp > XB_SPIN_CAP) { atomicAdd(&(bar)[XB_TMO], 1u); break; } } } } while (0)

struct XcdBarrier { unsigned* bar; unsigned x; volatile LAS unsigned* st; };

__device__ __forceinline__ XcdBarrier xcd_barrier_post(unsigned* bar, volatile LAS unsigned* st) {
    XcdBarrier b; b.bar = bar; b.x = xb_xcc_id(); b.st = st;
    if (threadIdx.x == 0) (void)xb_add(&bar[XB_XCNT(b.x)], 1u);
    return b;
}
__device__ __forceinline__ void xcd_barrier_complete(unsigned* bar, unsigned x, unsigned& nloc, unsigned& nx) {
    const unsigned G = gridDim.x * gridDim.y * gridDim.z;
    unsigned sum, cnt, mine, sp = 0u;
    for (;;) {
        sum = 0u; cnt = 0u; mine = 0u;
#pragma unroll
        for (unsigned j = 0; j < 16; ++j) { const unsigned c = xb_ld(&bar[XB_XCNT(j)]); sum += c; cnt += (c > 0u) ? 1u : 0u; mine = (j == x) ? c : mine; }
        if (sum == G) break;
        __builtin_amdgcn_s_sleep(1);
        if ((++sp & 255u) == 0u) { if (xb_ld(&bar[XB_TMO])) break; if (sp > XB_SPIN_CAP) { atomicAdd(&bar[XB_TMO], 1u); break; } }
    }
    nloc = mine > 0u ? mine : 1u; nx = cnt > 0u ? cnt : 1u;
}
__device__ __forceinline__ void xcd_barrier(const XcdBarrier& b) {
    asm volatile("s_waitcnt vmcnt(0)" ::: "memory");
    __syncthreads();
    if (threadIdx.x == 0) {
        unsigned* bar = b.bar;
        __builtin_amdgcn_s_waitcnt(0);
        unsigned nloc = b.st[0], nx = b.st[1];
        if (nloc == 0u) { xcd_barrier_complete(bar, b.x, nloc, nx); b.st[0] = nloc; b.st[1] = nx; }
        const unsigned old = xb_add(&bar[XB_XSUB(b.x)], 1u);
        const unsigned gen = old / nloc;
        if (old + 1u == (gen + 1u) * nloc) {
            __builtin_amdgcn_fence(__ATOMIC_RELEASE, "agent");
            asm volatile("s_waitcnt vmcnt(0)" ::: "memory");
            const unsigned og = xb_add(&bar[XB_TOP], 1u);
            const unsigned tg = og / nx;
            if (og + 1u == (tg + 1u) * nx) xb_add(&bar[XB_TOPGEN], 1u);
            else XB_SPIN(xb_ld(&bar[XB_TOPGEN]) == tg, bar);
            __builtin_amdgcn_fence(__ATOMIC_ACQUIRE, "agent");
            xb_add(&bar[XB_XGEN(b.x)], 1u);
            asm volatile("s_waitcnt vmcnt(0)" ::: "memory");
        } else {
            XB_SPIN(xb_ld(&bar[XB_XGEN(b.x)]) == gen, bar);
            __builtin_amdgcn_fence(__ATOMIC_ACQUIRE, "agent");
            asm volatile("s_waitcnt vmcnt(0)" ::: "memory");
        }
    }
    __syncthreads();
}

namespace pg8 {
constexpr int BM = 256, BK = 64, HALF = 128, HTB = HALF * BK * 2, STAGE_BYTES = 8 * HTB, NXCD = 8, WGM = 8;
__host__ __device__ __forceinline__ int lds_byte(int r, int c) { const int st = (r >> 4) * 2 + (c >> 5), rr = r & 15, cc = c & 31, ob = rr * 64 + cc * 2; return st * 1024 + (ob ^ (((ob >> 9) & 1) << 5)); }
__host__ __device__ __forceinline__ void stage_rc(int b, int& R, int& C) { const int st = b / 1024, sb = b % 1024, swz = sb ^ (((sb >> 9) & 1) << 5); R = (st >> 1) * 16 + swz / 64; C = (st & 1) * 32 + (swz % 64) / 2; }
__host__ __device__ __forceinline__ int perm32(int rho) { const int n = rho >> 4, i = rho & 15; return 8 * (i >> 2) + 4 * n + (i & 3); }

struct Unit { int pm, pn, ks; };
struct Gemm { const bf16_t* A; const bf16_t* Bt; int lda, ldb, K, agrp; size_t agrp_stride; };

struct StaticOrder {
    int nM, nN, nNe, nwg, G, c;
    __device__ void init(int nM_, int nN_, int KS, int G_, int c_) { nM = nM_; nN = nN_; nNe = nN_ * KS; nwg = nM * nNe; G = G_; c = c_; }
    __device__ bool next(int i, Unit& u) const {
        const long L = (long)i * G + c; if (L >= nwg) return false;
        int wgid = (int)L; { const int q = nwg / NXCD, r = nwg % NXCD, xcd = wgid % NXCD, off = wgid / NXCD; wgid = (xcd < r ? xcd * (q + 1) : r * (q + 1) + (xcd - r) * q) + off; }
        const int nig = WGM * nNe, gid = wgid / nig, fm = gid * WGM, gsz = (nM - fm) < WGM ? (nM - fm) : WGM;
        u.pm = fm + ((wgid % nig) % gsz); const int pne = (wgid % nig) / gsz; u.pn = pne % nN; u.ks = pne / nN; return true;
    }
};

enum { EPI_F32 = 0, EPI_RES = 1, EPI_BF16 = 2, EPI_RELU2 = 3, EPI_LW = 4, EPI_LA = 5, EPI_LV = 6 };
template <int MODE> struct Epi {
    static constexpr bool PERM = (MODE == EPI_BF16 || MODE == EPI_RELU2 || MODE == EPI_LA || MODE == EPI_LV);
    void* o0; void* o1; void* o2;
    const void* src;
    const float* vec;
    int ldc, split_cols; size_t ks_stride; float scale;
    bf16_t* xb = nullptr; unsigned long long* ss = nullptr;
    const unsigned long long* rss = nullptr;
    int res_mode = 0;
    unsigned* kmp = nullptr;
    int vperm = 0;
    int q8 = 0;
    const unsigned* wamax = nullptr;
    __device__ __forceinline__ void operator()(const f32x4 (&acc)[2][2][4][2], const Unit& u, int wr, int wc, int fr, int fq) const {
        int colt = u.pn * BM; void* basev = o0;
        int tsplit = 0;
        if (split_cols) { const int t = colt / split_cols; colt -= t * split_cols; basev = (t == 0) ? o0 : ((t == 1) ? o1 : o2); tsplit = t; }
        const int row0 = u.pm * BM + wr * 64 + fr;
        if constexpr (PERM) {
            bf16_t* base = (bf16_t*)basev + (size_t)u.ks * ks_stride;
            const int col0 = colt + wc * 32 + 8 * fq, vcol0 = u.pn * BM + wc * 32 + 8 * fq;
            float pmax[2] = {0.f, 0.f};
            f32x4 bv[2][2];
            if constexpr (MODE == EPI_LA || MODE == EPI_LV) {
#pragma unroll
                for (int bj = 0; bj < 2; ++bj)
#pragma unroll
                    for (int hf = 0; hf < 2; ++hf) bv[bj][hf] = *(const f32x4*)(vec + vcol0 + bj * HALF + 4 * hf);
            }
#pragma unroll
            for (int ai = 0; ai < 2; ++ai)
#pragma unroll
                for (int m = 0; m < 4; ++m) { const size_t roff = (size_t)(row0 + ai * HALF + m * 16) * ldc + col0; bf16_t* rowp = base + roff;
                    float rs = 1.f; if constexpr (MODE == EPI_RELU2 || MODE == EPI_BF16) { if (rss) rs = rsqrtf((float)rss[row0 + ai * HALF + m * 16] * (1.0f / (65536.0f * D)) + RMS_EPS); }
#pragma unroll
                    for (int bj = 0; bj < 2; ++bj) { f32x4 v0 = acc[ai][bj][m][0], v1 = acc[ai][bj][m][1];
                        if constexpr (MODE == EPI_RELU2) {
#pragma unroll
                            for (int j = 0; j < 4; ++j) { const float a = fmaxf(v0[j], 0.f) * rs, b = fmaxf(v1[j], 0.f) * rs; v0[j] = a * a; v1[j] = b * b; }
                        } else if constexpr (MODE == EPI_LA) {
#pragma unroll
                            for (int j = 0; j < 4; ++j) { v0[j] = sigmoidf_(v0[j] + bv[bj][0][j]); v1[j] = sigmoidf_(v1[j] + bv[bj][1][j]); }
                        } else if constexpr (MODE == EPI_LV) {
                            const u32x4 cw = *(const u32x4*)(rowp + bj * HALF), fw = *(const u32x4*)((const bf16_t*)src + roff + bj * HALF);
#pragma unroll
                            for (int j = 0; j < 4; ++j) { const unsigned cu = cw[j >> 1], fu = fw[j >> 1], cu1 = cw[2 + (j >> 1)], fu1 = fw[2 + (j >> 1)];
                                const float c0 = __builtin_bit_cast(float, (j & 1) ? (cu & 0xffff0000u) : (cu << 16)), f0 = __builtin_bit_cast(float, (j & 1) ? (fu & 0xffff0000u) : (fu << 16));
                                const float c1 = __builtin_bit_cast(float, (j & 1) ? (cu1 & 0xffff0000u) : (cu1 << 16)), f1 = __builtin_bit_cast(float, (j & 1) ? (fu1 & 0xffff0000u) : (fu1 << 16));
                                v0[j] = c0 + (f0 - c0) * sigmoidf_(v0[j] + bv[bj][0][j]); v1[j] = c1 + (f1 - c1) * sigmoidf_(v1[j] + bv[bj][1][j]); }
                        } else { v0 = v0 * (scale * rs); v1 = v1 * (scale * rs);
                            if constexpr (MODE == EPI_BF16) { if (kmp && tsplit == 1) { float ps = ((v0[0] * v0[0] + v0[1] * v0[1]) + (v0[2] * v0[2] + v0[3] * v0[3])) + ((v1[0] * v1[0] + v1[1] * v1[1]) + (v1[2] * v1[2] + v1[3] * v1[3]));
                                ps += __shfl_xor(ps, 16); ps += __shfl_xor(ps, 32); pmax[bj] = fmaxf(pmax[bj], ps); } } }
                        if constexpr (MODE == EPI_RELU2) { if (q8) {
                            const u32x2 w8 = (u32x2){pk_fp8x4(v0[0] * U8_SCALE, v0[1] * U8_SCALE, v0[2] * U8_SCALE, v0[3] * U8_SCALE), pk_fp8x4(v1[0] * U8_SCALE, v1[1] * U8_SCALE, v1[2] * U8_SCALE, v1[3] * U8_SCALE)};
                            *(GAS u32x2*)((unsigned char*)basev + roff + bj * HALF) = w8; continue; } }
                        u32x4 w; w.x = cvt_pk_bf16(v0[0], v0[1]); w.y = cvt_pk_bf16(v0[2], v0[3]); w.z = cvt_pk_bf16(v1[0], v1[1]); w.w = cvt_pk_bf16(v1[2], v1[3]);
                        if constexpr (MODE == EPI_BF16) { if (vperm) { bf16_t* p_ = rowp + bj * HALF - 4 * (fq & 1); *(GAS u32x2*)p_ = (u32x2){w.x, w.y}; *(GAS u32x2*)(p_ + 8) = (u32x2){w.z, w.w}; continue; } }
                        *(u32x4*)(rowp + bj * HALF) = w; } }
            if constexpr (MODE == EPI_BF16) { if (kmp && tsplit == 1) {
#pragma unroll
                for (int bj = 0; bj < 2; ++bj) { float pm = pmax[bj]; pm = fmaxf(pm, __shfl_xor(pm, 1)); pm = fmaxf(pm, __shfl_xor(pm, 2)); pm = fmaxf(pm, __shfl_xor(pm, 4)); pm = fmaxf(pm, __shfl_xor(pm, 8));
                    if (fr == 0 && fq == 0) atomicMax(kmp + (colt / 128 + bj) * 4 + wc, __builtin_bit_cast(unsigned, pm)); } } }
        } else {
            float* base = (float*)basev + (size_t)u.ks * ks_stride;
            const int col0 = colt + wc * 32 + 4 * fq, vcol0 = u.pn * BM + wc * 32 + 4 * fq;
            f32x4 bv[2][2];
            if constexpr (MODE == EPI_LW) {
#pragma unroll
                for (int bj = 0; bj < 2; ++bj)
#pragma unroll
                    for (int n = 0; n < 2; ++n) bv[bj][n] = *(const f32x4*)(vec + vcol0 + bj * HALF + n * 16);
            }
            if constexpr (MODE == EPI_RES) {
                const float osc = wamax ? w8_inv_scale(__hip_atomic_load(wamax, __ATOMIC_RELAXED, __HIP_MEMORY_SCOPE_AGENT)) * (1.0f / U8_SCALE) : 1.0f;
#pragma unroll
                for (int ai = 0; ai < 2; ++ai) {
                    f32x4 sv[4][2][2];
                    if (res_mode >= 2) {
#pragma unroll
                        for (int m = 0; m < 4; ++m)
#pragma unroll
                            for (int bj = 0; bj < 2; ++bj)
#pragma unroll
                                for (int n = 0; n < 2; ++n) { const u32x2 w_ = *(const GAS u32x2*)((const bf16_t*)src + (size_t)(row0 + ai * HALF + m * 16) * ldc + col0 + bj * HALF + n * 16);
                                    sv[m][bj][n] = (f32x4){__builtin_bit_cast(float, w_.x << 16), __builtin_bit_cast(float, w_.x & 0xffff0000u), __builtin_bit_cast(float, w_.y << 16), __builtin_bit_cast(float, w_.y & 0xffff0000u)}; }
                    } else {
#pragma unroll
                    for (int m = 0; m < 4; ++m)
#pragma unroll
                        for (int bj = 0; bj < 2; ++bj)
#pragma unroll
                            for (int n = 0; n < 2; ++n) sv[m][bj][n] = *(const GAS f32x4*)((const float*)src + (size_t)(row0 + ai * HALF + m * 16) * ldc + col0 + bj * HALF + n * 16);
                    }
#pragma unroll
                    for (int m = 0; m < 4; ++m) { const size_t roff = (size_t)(row0 + ai * HALF + m * 16) * ldc + col0; float psum = 0.f;
#pragma unroll
                        for (int bj = 0; bj < 2; ++bj)
#pragma unroll
                            for (int n = 0; n < 2; ++n) { const size_t off = roff + bj * HALF + n * 16; const f32x4 v = acc[ai][bj][m][n] * osc + sv[m][bj][n];
                                if (xb) *(GAS u32x2*)(xb + off) = (u32x2){cvt_pk_bf16(v[0], v[1]), cvt_pk_bf16(v[2], v[3])};
                                if (ss) psum += (v[0] * v[0] + v[1] * v[1]) + (v[2] * v[2] + v[3] * v[3]);
                                if (res_mode == 0 || res_mode == 2) *(GAS f32x4*)(base + off) = v; }
                        if (ss) { psum += __shfl_xor(psum, 16); psum += __shfl_xor(psum, 32); if (fq == 0) atomicAdd(ss + row0 + ai * HALF + m * 16, (unsigned long long)(psum * 65536.0f)); } }
                }
            } else {
#pragma unroll
            for (int ai = 0; ai < 2; ++ai)
#pragma unroll
                for (int m = 0; m < 4; ++m) { const size_t roff = (size_t)(row0 + ai * HALF + m * 16) * ldc + col0;
#pragma unroll
                    for (int bj = 0; bj < 2; ++bj)
#pragma unroll
                        for (int n = 0; n < 2; ++n) { const size_t off = roff + bj * HALF + n * 16; f32x4 v = acc[ai][bj][m][n];
                            if constexpr (MODE == EPI_LW) {
#pragma unroll
                                for (int j = 0; j < 4; ++j) { const float uu = v[j] + bv[bj][n][j]; const float wl = -softplusf_(-uu) - 0.5f; v[j] = -__expf(wl); }
                                *(GAS u32x2*)((_Float16*)basev + off) = (u32x2){cvt_pk_f16(v[0], v[1]), cvt_pk_f16(v[2], v[3])}; continue; }
                            *(f32x4*)(base + off) = v; } }
            }
        }
    }
};

template <class EpiT, bool F8 = false>
__device__ __forceinline__ void gemm_phase(LAS unsigned char* lds, const Gemm g, const StaticOrder& S_, const EpiT& E, const int tid) {
    const int wid = __builtin_amdgcn_readfirstlane(tid >> 6), lane = tid & 63, wr = wid >> 2, wc = wid & 3, fr = lane & 15, fq = lane >> 4;
    int K = g.K, lda_ = g.lda, ldb_ = g.ldb; asm volatile("" : "+s"(K), "+s"(lda_), "+s"(ldb_));
    const int nt = K / BK;
    unsigned voffA[2], voffB[2];
#pragma unroll
    for (int i = 0; i < 2; ++i) { int R, C; stage_rc(tid * 16 + i * 8192, R, C); const int Rb = EpiT::PERM ? ((R & ~31) + perm32(R & 31)) : R;
        voffA[i] = (unsigned)(R * lda_ + C) * 2u; voffB[i] = (unsigned)(Rb * ldb_ + C) * 2u; }
    const size_t kstep = (size_t)(BK * 2);
    const size_t hstepA = (size_t)HALF * lda_ * 2, hstepB = (size_t)HALF * ldb_ * 2;
    const unsigned ldsw = (unsigned)wid * 1024u;
    const int aoff = lds_byte(wr * 64 + fr, fq * 8), boff = lds_byte(wc * 32 + fr, fq * 8);
#define PG8_SA(b, h) (((b) * 2 + (h)) * HTB)
#define PG8_SB(b, h) ((4 + (b) * 2 + (h)) * HTB)
#define PG8_STAGE(bufoff, gbase, voff) do { _Pragma("unroll") for (int _i = 0; _i < 2; ++_i) \
        __builtin_amdgcn_global_load_lds((const unsigned*)((const char*)(gbase) + (voff)[_i]), (LAS unsigned*)(lds + (bufoff) + ldsw + _i * 8192), 16, 0, 0); } while (0)
#define PG8_LDA(dst, b, h) do { _Pragma("unroll") for (int m = 0; m < 4; ++m) _Pragma("unroll") for (int k = 0; k < 2; ++k) dst[m][k] = *(const LAS bf16x8*)(lds + PG8_SA(b, h) + aoff + m * 2048 + k * 1024); } while (0)
#define PG8_LDB(dst, b, h) do { _Pragma("unroll") for (int n = 0; n < 2; ++n) _Pragma("unroll") for (int k = 0; k < 2; ++k) dst[n][k] = *(const LAS bf16x8*)(lds + PG8_SB(b, h) + boff + n * 2048 + k * 1024); } while (0)
#define PG8_MMA(ai, bj, At, Bt) do { __builtin_amdgcn_s_setprio(1); _Pragma("unroll") for (int m = 0; m < 4; ++m) _Pragma("unroll") for (int n = 0; n < 2; ++n) { \
        if constexpr (F8) { const i32x8 a8_ = __builtin_shufflevector(__builtin_bit_cast(i32x4, At[m][0]), __builtin_bit_cast(i32x4, At[m][1]), 0, 1, 2, 3, 4, 5, 6, 7); \
            const i32x8 b8_ = __builtin_shufflevector(__builtin_bit_cast(i32x4, Bt[n][0]), __builtin_bit_cast(i32x4, Bt[n][1]), 0, 1, 2, 3, 4, 5, 6, 7); \
            asm volatile("v_mfma_f32_16x16x128_f8f6f4 %0, %1, %2, %0" : "+v"(acc[ai][bj][m][n]) : "v"(b8_), "v"(a8_)); \
        } else { _Pragma("unroll") for (int k = 0; k < 2; ++k) acc[ai][bj][m][n] = __builtin_amdgcn_mfma_f32_16x16x32_bf16(Bt[n][k], At[m][k], acc[ai][bj][m][n], 0, 0, 0); } } \
        __builtin_amdgcn_s_setprio(0); } while (0)
#define PG8_WAIT_V(n) asm volatile("s_waitcnt vmcnt(" #n ")" ::: "memory")
#define PG8_WAIT_L(n) asm volatile("s_waitcnt lgkmcnt(" #n ")" ::: "memory")
#define PG8_BAR __builtin_amdgcn_s_barrier()
#define PG8_SCHED __builtin_amdgcn_sched_barrier(0)
#define PG8_UPTR(u, pa, pb) do { pa = (const char*)g.A + ((size_t)((u).pn / g.agrp) * g.agrp_stride + (size_t)(u).pm * BM * lda_ + (size_t)(u).ks * K) * 2; \
                                 pb = (const char*)g.Bt + ((size_t)(u).pn * BM * ldb_ + (size_t)(u).ks * K) * 2; } while (0)
    Unit cur, nxt; int ui = 0;
    if (!S_.next(0, cur)) return;
    f32x4 acc[2][2][4][2];
#pragma unroll
    for (int a = 0; a < 2; ++a)
#pragma unroll
        for (int b = 0; b < 2; ++b)
#pragma unroll
            for (int m = 0; m < 4; ++m)
#pragma unroll
                for (int n = 0; n < 2; ++n) acc[a][b][m][n] = (f32x4){0.f, 0.f, 0.f, 0.f};
    bf16x8 At[4][2], B0[2][2], B1[2][2];
    const char* cA; const char* cB; PG8_UPTR(cur, cA, cB);
    PG8_STAGE(PG8_SB(0, 0), cB, voffB); PG8_STAGE(PG8_SB(0, 1), cB + hstepB, voffB); PG8_STAGE(PG8_SA(0, 0), cA, voffA); PG8_STAGE(PG8_SA(0, 1), cA + hstepA, voffA);
    if (wr == 1) PG8_BAR;
    PG8_WAIT_V(2); PG8_BAR;
    PG8_STAGE(PG8_SB(1, 0), cB + kstep, voffB); PG8_STAGE(PG8_SA(1, 0), cA + kstep, voffA); PG8_STAGE(PG8_SB(1, 1), cB + hstepB + kstep, voffB);
    PG8_WAIT_V(6); PG8_BAR;
    for (;;) {
        const bool has_next = S_.next(ui + 1, nxt);
        const char* nA = cA; const char* nB = cB; if (has_next) PG8_UPTR(nxt, nA, nB);
        for (int t = 0; t < nt; t += 2) {
            const bool last = (t == nt - 2);
            const char* a1 = cA + (size_t)(t + 1) * kstep;
            const char* a2 = last ? nA : cA + (size_t)(t + 2) * kstep; const char* b2 = last ? nB : cB + (size_t)(t + 2) * kstep;
            const char* a3 = a2 + kstep; const char* b3 = b2 + kstep;
            PG8_LDB(B0, 0, 0); PG8_LDB(B1, 0, 1); PG8_SCHED; PG8_LDA(At, 0, 0); PG8_STAGE(PG8_SA(1, 1), a1 + hstepA, voffA);
            PG8_WAIT_V(8); PG8_WAIT_L(0); PG8_BAR; PG8_MMA(0, 0, At, B0); PG8_MMA(0, 1, At, B1); PG8_BAR; PG8_SCHED;
            PG8_LDA(At, 0, 1); PG8_STAGE(PG8_SB(0, 0), b2, voffB); PG8_STAGE(PG8_SB(0, 1), b2 + hstepB, voffB); PG8_STAGE(PG8_SA(0, 0), a2, voffA);
            PG8_WAIT_V(8); PG8_WAIT_L(0); PG8_BAR; PG8_MMA(1, 0, At, B0); PG8_MMA(1, 1, At, B1); PG8_BAR; PG8_SCHED;
            PG8_LDB(B0, 1, 0); PG8_LDB(B1, 1, 1); PG8_SCHED; PG8_LDA(At, 1, 0); PG8_STAGE(PG8_SA(0, 1), a2 + hstepA, voffA);
            PG8_WAIT_V(8); PG8_WAIT_L(0); PG8_BAR; PG8_MMA(0, 0, At, B0); PG8_MMA(0, 1, At, B1); PG8_BAR; PG8_SCHED;
            PG8_LDA(At, 1, 1); PG8_STAGE(PG8_SB(1, 0), b3, voffB); PG8_STAGE(PG8_SB(1, 1), b3 + hstepB, voffB); PG8_STAGE(PG8_SA(1, 0), a3, voffA);
            PG8_WAIT_V(8); PG8_WAIT_L(0); PG8_BAR; PG8_MMA(1, 0, At, B0); PG8_MMA(1, 1, At, B1); PG8_BAR; PG8_SCHED;
        }
        if constexpr (F8) asm volatile("s_nop 15\n\ts_nop 15" ::: "memory");
        if (wr == 0) PG8_BAR;
        E(acc, cur, wr, wc, fr, fq);
        if (!has_next) break;
#pragma unroll
        for (int a = 0; a < 2; ++a)
#pragma unroll
            for (int b = 0; b < 2; ++b)
#pragma unroll
                for (int m = 0; m < 4; ++m)
#pragma unroll
                    for (int n = 0; n < 2; ++n) acc[a][b][m][n] = (f32x4){0.f, 0.f, 0.f, 0.f};
        cur = nxt; cA = nA; cB = nB; ++ui;
        if (wr == 1) PG8_BAR;
    }
    PG8_WAIT_V(0);
    PG8_BAR;
#undef PG8_SA
#undef PG8_SB
#undef PG8_STAGE
#undef PG8_LDA
#undef PG8_LDB
#undef PG8_MMA
#undef PG8_WAIT_V
#undef PG8_WAIT_L
#undef PG8_BAR
#undef PG8_SCHED
#undef PG8_UPTR
}
}

constexpr int CONV_SCR = 4344;
__device__ __forceinline__ void conv_issue(f32x4 (&v)[8], const float* W, int ldw, int lane, bool f8 = false) {
    const int lr8 = lane >> 3, lc = (lane & 7) * 4;
#pragma unroll
    for (int i = 0; i < 8; ++i) v[i] = __builtin_nontemporal_load((const GAS f32x4*)(W + (size_t)(f8 ? 32 * (i >> 2) + 4 * lr8 + (i & 3) : 16 * (i >> 1) + 2 * lr8 + (i & 1)) * ldw + lc));
}
__device__ __forceinline__ void conv_finish(const f32x4 (&v)[8], bf16_t* WT, int ldt, const float* sc, int smode, LAS unsigned* scr, int lane) {
    const int lr8 = lane >> 3, l7 = lane & 7;
    if (smode == 3) {
        const float s8 = w8_scale(__hip_atomic_load((const unsigned*)sc, __ATOMIC_RELAXED, __HIP_MEMORY_SCOPE_AGENT));
#pragma unroll
        for (int m = 0; m < 2; ++m)
#pragma unroll
            for (int e = 0; e < 4; ++e) scr[(4 * l7 + e) * 18 + 8 * m + lr8] = pk_fp8x4(v[4 * m][e] * s8, v[4 * m + 1][e] * s8, v[4 * m + 2][e] * s8, v[4 * m + 3][e] * s8);
        asm volatile("s_waitcnt lgkmcnt(0)" ::: "memory");
#pragma unroll
        for (int j = 0; j < 4; ++j) { const int n = lr8 + 8 * j; const u32x2 o = *(const LAS u32x2*)(scr + n * 18 + 2 * l7);
            *(GAS u32x2*)((unsigned char*)WT + (size_t)n * ldt + 8 * l7) = o; }
        asm volatile("s_waitcnt lgkmcnt(0)" ::: "memory");
        return;
    }
#pragma unroll
    for (int m = 0; m < 4; ++m) { f32x4 lo = v[2 * m], hi = v[2 * m + 1];
        if (smode) { const f32x2_t sv_ = *(const GAS f32x2_t*)(sc + 16 * m + 2 * lr8); float s0 = sv_[0], s1 = sv_[1]; if (smode == 2) { s0 = 1.0f - s0; s1 = 1.0f - s1; } lo = lo * s0; hi = hi * s1; }
#pragma unroll
        for (int e = 0; e < 4; ++e) scr[(4 * l7 + e) * 34 + 8 * m + lr8] = cvt_pk_bf16(lo[e], hi[e]); }
    asm volatile("s_waitcnt lgkmcnt(0)" ::: "memory");
#pragma unroll
    for (int j = 0; j < 4; ++j) { const int n = lr8 + 8 * j; const LAS unsigned* p = scr + n * 34 + 4 * l7;
        const u32x2 o0 = *(const LAS u32x2*)p, o1 = *(const LAS u32x2*)(p + 2);
        *(GAS u32x4*)(WT + (size_t)n * ldt + 8 * l7) = (u32x4){o0.x, o0.y, o1.x, o1.y}; }
    asm volatile("s_waitcnt lgkmcnt(0)" ::: "memory");
}
__device__ __forceinline__ void conv_tile(const float* W, int ldw, bf16_t* WT, int ldt, int k0, int n0, int dst_row0, int dst_col0,
                                          const float* sc, int smode, LAS float* scr, int lane) {
    f32x4 v[8];
    conv_issue(v, W + (size_t)k0 * ldw + n0, ldw, lane);
    conv_finish(v, WT + (size_t)dst_row0 * ldt + dst_col0 + k0, ldt, sc + k0, smode, (LAS unsigned*)scr, lane);
}
__device__ __forceinline__ void conv_job(const float* W, int ldw, int K, int N, int n_begin, bf16_t* WT, int ldt, int row_off, int col_off,
                                         const float* sc, int smode, LAS float* scr, int lane, int gw, int NGW) {
    const int nblk = N / 32, nitems = (K / 64) * nblk;
    for (int it = gw; it < nitems; it += NGW) { const int kb = it / nblk, nb = it % nblk;
        conv_tile(W, ldw, WT, ldt, 64 * kb, n_begin + 32 * nb, row_off + 32 * nb, col_off, sc, smode, scr, lane); }
}
__device__ __forceinline__ void conv_lu(const float* W, int Kr, bf16_t* WT, int gtid, int GT) {
    for (int idx = gtid; idx < 32 * 2048; idx += GT) { const int n = idx & 2047, kc = idx >> 11; float v[8];
#pragma unroll
        for (int i = 0; i < 8; ++i) { const int k = kc * 8 + i; v[i] = (k < Kr) ? W[(size_t)k * 2048 + n] : 0.f; }
        u32x4 o; o.x = cvt_pk_bf16(v[0], v[1]); o.y = cvt_pk_bf16(v[2], v[3]); o.z = cvt_pk_bf16(v[4], v[5]); o.w = cvt_pk_bf16(v[6], v[7]);
        *(u32x4*)(WT + (size_t)n * 256 + kc * 8) = o; }
}

__device__ __forceinline__ void touch_weights(const void* p, size_t bytes, LAS unsigned char* lds, int wave, int gw, int NGW, int lane) {
    LAS unsigned char* junk = lds + 131072 + wave * 1024;
    for (size_t o = (size_t)gw * 1024; o < bytes; o += (size_t)NGW * 1024)
        __builtin_amdgcn_global_load_lds((const unsigned*)((const unsigned char*)p + o + lane * 16), (LAS unsigned*)junk, 16, 0, 0);
}

struct Args { const float* in[30]; float* out; unsigned char* ws; int ph_lo, ph_hi; };

__device__ __forceinline__ float row_rstd(const f32x4 (&v)[8]) {
    float s = 0.f;
#pragma unroll
    for (int j = 0; j < 8; ++j) s += (v[j].x * v[j].x + v[j].y * v[j].y) + (v[j].z * v[j].z + v[j].w * v[j].w);
    return rsqrtf(wave_sum(s) * (1.0f / D) + RMS_EPS);
}
__device__ __forceinline__ void store_bf16x4(bf16_t* p, f32x4 v) { u32x2 o; o.x = cvt_pk_bf16(v.x, v.y); o.y = cvt_pk_bf16(v.z, v.w); *(u32x2*)p = o; }

__device__ __forceinline__ void load_row(f32x4 (&v)[8], const void* x, bool isbf, int t, int lane) {
    if (isbf) { const u32x2* xr = (const u32x2*)((const bf16_t*)x + (size_t)t * D) + lane;
#pragma unroll
        for (int j = 0; j < 8; ++j) { const u32x2 w_ = xr[64 * j]; v[j] = (f32x4){__builtin_bit_cast(float, w_.x << 16), __builtin_bit_cast(float, w_.x & 0xffff0000u), __builtin_bit_cast(float, w_.y << 16), __builtin_bit_cast(float, w_.y & 0xffff0000u)}; }
    } else { const f32x4* xr = (const f32x4*)((const float*)x + (size_t)t * D) + lane;
#pragma unroll
        for (int j = 0; j < 8; ++j) v[j] = xr[64 * j]; }
}
__device__ __forceinline__ void phase_r1(const void* x, bool isbf, const float* gain, const float* mix, bf16_t* hbuf, bf16_t* xs, int gw, int NGW, int lane) {
    for (int t = gw; t < S; t += NGW) {
        f32x4 xv[8], pv[8];
        load_row(xv, x, isbf, t, lane);
        if (t > 0) { load_row(pv, x, isbf, t - 1, lane);
        } else {
#pragma unroll
            for (int j = 0; j < 8; ++j) pv[j] = (f32x4){0.f, 0.f, 0.f, 0.f};
        }
        const float rs = row_rstd(xv), rp = row_rstd(pv);
#pragma unroll
        for (int j = 0; j < 8; ++j) { const int c = 4 * (lane + 64 * j); const f32x4 gv = *(const f32x4*)(gain + c);
            const f32x4 h = xv[j] * rs * gv, hp = pv[j] * rp * gv, d = hp - h;
            store_bf16x4(hbuf + (size_t)(t + 1) * D + c, h);
            if (t == 0) store_bf16x4(hbuf + c, (f32x4){0.f, 0.f, 0.f, 0.f});
#pragma unroll
            for (int q = 0; q < 3; ++q) { const f32x4 mv = *(const f32x4*)(mix + q * D + c); store_bf16x4(xs + (size_t)q * S * D + (size_t)t * D + c, h + d * mv); }
        }
    }
}
__device__ __forceinline__ void phase_final(float* x, const float* g0, int gw, int NGW, int lane) {
    for (int t = gw; t < S; t += NGW) {
        f32x4 xv[8]; f32x4* xr = (f32x4*)(x + (size_t)t * D) + lane;
#pragma unroll
        for (int j = 0; j < 8; ++j) xv[j] = xr[64 * j];
        const float rs = row_rstd(xv);
#pragma unroll
        for (int j = 0; j < 8; ++j) { const int c = 4 * (lane + 64 * j); xr[64 * j] = xv[j] * rs * *(const f32x4*)(g0 + c); }
    }
}
__device__ __forceinline__ void phase_f0(const bf16_t* x, const float* gq, bf16_t* hq, const float* gk, bf16_t* hk, const float* wkvf, const float* bf, float* lf,
                                         LAS float* wl, int gw, int NGW, int lane, int tid) {
    for (int i = tid; i < D * FH; i += 512) { const int d = i >> 4, j = i & 15; wl[j * D + d] = wkvf[(size_t)d * KVF_LD + 2 * D + j]; }
    __syncthreads();
    for (int t = gw; t < S; t += NGW) {
        f32x4 xv[8]; load_row(xv, x, true, t, lane);
        const float rs = row_rstd(xv);
        LAS float* wl_ = wl; asm volatile("" : "+v"(wl_));
        float fa[FH];
#pragma unroll
        for (int j = 0; j < FH; ++j) fa[j] = 0.f;
#pragma unroll
        for (int j = 0; j < 8; ++j) { const int c = 4 * (lane + 64 * j); const f32x4 xn = xv[j] * rs; const f32x4 hkv = xn * *(const f32x4*)(gk + c);
            store_bf16x4(hq + (size_t)t * D + c, xn * *(const f32x4*)(gq + c));
            store_bf16x4(hk + (size_t)t * D + c, hkv);
#pragma unroll
            for (int q = 0; q < FH; ++q) { const f32x4 w = *(const LAS f32x4*)(wl_ + q * D + c); fa[q] += (hkv.x * w.x + hkv.y * w.y) + (hkv.z * w.z + hkv.w * w.w); }
        }
#pragma unroll
        for (int q = 0; q < FH; ++q) fa[q] = wave_sum(fa[q]);
        if (lane < FH) { float z = 0.f;
#pragma unroll
            for (int q = 0; q < FH; ++q) z = (lane == q) ? fa[q] : z;
            z += bf[lane]; lf[(size_t)t * FH + lane] = -softplusf_(-z); }
    }
}
__device__ __forceinline__ void phase_cumsum(const float* lf, float* cs2, int hd, LAS double* sc, int tid) {
    const int lane = tid & 63, wid = tid >> 6;
    double loc[16]; double s = 0.0;
#pragma unroll
    for (int i = 0; i < 16; ++i) { s += (double)lf[(size_t)(tid * 16 + i) * FH + hd]; loc[i] = s; }
    double incl = s;
#pragma unroll
    for (int o = 1; o < 64; o <<= 1) { const double up = __shfl_up(incl, o); if (lane >= o) incl += up; }
    if (lane == 63) sc[wid] = incl;
    __syncthreads();
    double base = incl - s;
    for (int w = 0; w < wid; ++w) base += sc[w];
#pragma unroll
    for (int i = 0; i < 16; ++i) cs2[(size_t)hd * S + tid * 16 + i] = (float)(-(base + loc[i]) * (double)LOG2E);
    __syncthreads();
}
__device__ __forceinline__ void phase_r3(const bf16_t* part, bf16_t* act, int gtid, int GT) {
    for (int idx = gtid; idx < S * 128; idx += GT) { const int t = idx >> 7, c = (idx & 127) * 4;
        f32x4 v = (f32x4){0.f, 0.f, 0.f, 0.f};
#pragma unroll
        for (int p = 0; p < 4; ++p) { const u32x2 w_ = *(const u32x2*)(part + (size_t)p * S * LORA_N + (size_t)t * LORA_N + c);
            v = v + (f32x4){__builtin_bit_cast(float, w_.x << 16), __builtin_bit_cast(float, w_.x & 0xffff0000u), __builtin_bit_cast(float, w_.y << 16), __builtin_bit_cast(float, w_.y & 0xffff0000u)}; }
        if (c < 96) { f32x4 o; o.x = tanhf(v.x); o.y = tanhf(v.y); o.z = tanhf(v.z); o.w = tanhf(v.w); store_bf16x4(act + (size_t)t * 256 + c, o); }
        else if (c < 192) store_bf16x4(act + (size_t)S * 256 + (size_t)t * 256 + (c - 96), v);
        else if (c < 256) store_bf16x4(act + (size_t)2 * S * 256 + (size_t)t * 256 + (c - 192), v);
        else { f32x4 o; o.x = sigmoidf_(v.x); o.y = sigmoidf_(v.y); o.z = sigmoidf_(v.z); o.w = sigmoidf_(v.w); store_bf16x4(act + (size_t)3 * S * 256 + (size_t)t * 256 + (c - 256), o); }
        const int z = idx & 127;
        if (z < 40) { store_bf16x4(act + (size_t)t * 256 + 96 + 4 * z, (f32x4){0.f, 0.f, 0.f, 0.f}); store_bf16x4(act + (size_t)S * 256 + (size_t)t * 256 + 96 + 4 * z, (f32x4){0.f, 0.f, 0.f, 0.f}); }
        if (z < 48) store_bf16x4(act + (size_t)2 * S * 256 + (size_t)t * 256 + 64 + 4 * z, (f32x4){0.f, 0.f, 0.f, 0.f});
    }
}

__device__ __forceinline__ float dpp_f(float v, const int ctrl_sel) {
    int r;
    if (ctrl_sel == 0) r = __builtin_amdgcn_update_dpp(0, __builtin_bit_cast(int, v), 0xB1, 0xF, 0xF, true);
    else if (ctrl_sel == 1) r = __builtin_amdgcn_update_dpp(0, __builtin_bit_cast(int, v), 0x4E, 0xF, 0xF, true);
    else if (ctrl_sel == 2) r = __builtin_amdgcn_update_dpp(0, __builtin_bit_cast(int, v), 0x141, 0xF, 0xF, true);
    else r = __builtin_amdgcn_update_dpp(0, __builtin_bit_cast(int, v), 0x140, 0xF, 0xF, true);
    return __builtin_bit_cast(float, r);
}
__device__ __forceinline__ float red16(float v) { v += dpp_f(v, 0); v += dpp_f(v, 1); v += dpp_f(v, 2); v += dpp_f(v, 3); return v; }

constexpr int NCHUNK = S / 64, NUNIT = RH * NCHUNK;
typedef const __attribute__((address_space(4))) unsigned long long* KP;
#ifndef RIDE
#define RIDE 1
#endif
#ifndef C2_CONV_FROM
#define C2_CONV_FROM 16384
#endif
struct ConvD { const float* W; bf16_t* WT; const float* sc; int ldw, ldt, smode; };
__device__ __forceinline__ int c1_conv_ntiles(int l) { return l == 0 ? 32768 : 32768 + 6 * 2048; }
__device__ __forceinline__ ConvD c1_conv_desc(KP kp, int l, int T) {
    unsigned char* ws = (unsigned char*)(GAS unsigned char*)kp[31];
    ConvD d; int t, nblk;
    if (T < 32768) { const int j = T >> 13; t = T & 8191;
        const int lay = (j < 2) ? l : 3 - l;
        if ((j & 1) == 0) { d.W = (const float*)(const GAS float*)kp[28] + (size_t)lay * D * FF; d.ldw = FF; nblk = FF / 32; d.ldt = D; d.sc = (const float*)(const GAS float*)kp[2] + (size_t)lay * D; d.smode = 1;
            d.WT = (bf16_t*)(ws + (j < 2 ? WS_WUP01 + (size_t)l * D * FF * 2 : (l == 0 ? WS_WUP3 : WS_WUP2))); }
        else { d.W = (const float*)(const GAS float*)kp[29] + (size_t)lay * D * FF; d.ldw = D; nblk = D / 32; d.ldt = FF; d.sc = nullptr; d.smode = 0;
            d.WT = (bf16_t*)(ws + (j < 2 ? WS_WDN01 + (size_t)l * D * FF * 2 : (l == 0 ? WS_WDN3 : WS_WDN2))); }
        if ((j & 1) && ((F8_M3_MASK >> lay) & 1)) { d.smode = 3; d.sc = (const float*)((const unsigned*)(ws + WS_CTL) + CW_WAMAX + lay); }
    } else { const int j = (T - 32768) >> 11; t = T & 2047; nblk = D / 32; d.ldt = D; d.ldw = D; d.sc = nullptr; d.smode = 0;
        if (j == 0) { d.W = (const float*)(const GAS float*)kp[26]; d.WT = (bf16_t*)(ws + WS_WQK); }
        else if (j == 1) { d.W = (const float*)(const GAS float*)kp[24]; d.ldw = KVF_LD; d.WT = (bf16_t*)(ws + WS_WQK) + (size_t)D * D; }
        else if (j == 2) { d.W = (const float*)(const GAS float*)kp[24] + D; d.ldw = KVF_LD; d.WT = (bf16_t*)(ws + WS_WV); }
        else if (j == 3) { d.W = (const float*)(const GAS float*)kp[26] + (size_t)D * D; d.WT = (bf16_t*)(ws + WS_WQ3); d.sc = (const float*)(const GAS float*)kp[1] + (size_t)3 * D; d.smode = 1; }
        else { d.W = (const float*)(const GAS float*)kp[27] + (size_t)(j - 4) * D * D; d.WT = (bf16_t*)(ws + WS_WFO) + (size_t)(j - 4) * D * D; }
    }
    const int kb = t / nblk, nb = t % nblk;
    d.W += (size_t)(64 * kb) * d.ldw + 32 * nb;
    if (d.smode == 3) d.WT = (bf16_t*)((unsigned char*)d.WT + (size_t)(32 * nb) * d.ldt + 64 * kb);
    else { d.WT += (size_t)(32 * nb) * d.ldt + 64 * kb; if (d.smode) d.sc += 64 * kb; }
    return d;
}
__device__ __forceinline__ int c1_conv_split(int l, int G) { const int tot = c1_conv_ntiles(l); return (G > RH * 4) ? (tot < C2_CONV_FROM ? tot : C2_CONV_FROM) : tot; }
__device__ __forceinline__ void c1_conv_range(KP kp, int l, int t0, int t1, int stride, LAS unsigned* scr, int lane) {
    f32x4 va[8], vb[8];
    int T = t0;
    if (T < t1) { const ConvD d_ = c1_conv_desc(kp, l, T); conv_issue(va, d_.W, d_.ldw, lane, d_.smode == 3); }
    while (T < t1) {
        const int T2 = T + stride, T3 = T2 + stride;
        if (T2 < t1) { const ConvD d_ = c1_conv_desc(kp, l, T2); conv_issue(vb, d_.W, d_.ldw, lane, d_.smode == 3); }
        { const ConvD d_ = c1_conv_desc(kp, l, T); conv_finish(va, d_.WT, d_.ldt, d_.sc, d_.smode, scr, lane); }
        if (T2 < t1) {
            if (T3 < t1) { const ConvD d_ = c1_conv_desc(kp, l, T3); conv_issue(va, d_.W, d_.ldw, lane, d_.smode == 3); }
            const ConvD d_ = c1_conv_desc(kp, l, T2); conv_finish(vb, d_.WT, d_.ldt, d_.sc, d_.smode, scr, lane);
        }
        T = T3;
    }
}
namespace ck {
constexpr int CB = 9216, CST = 144;
enum { L_A = 0, L_AT = 1, L_B = 2, L_K = 3, L_R = 4, L_VT = 5, L_KHT = 6, L_BHT = 7, L_P0 = 8, L_PT0 = 9, L_NT0 = 10, L_AAK = 11, L_ARK = 12, L_ARB = 13,
       L_P1 = 2, L_PT1 = 3, L_NT1 = 7, L_N = 7, L_X1T = 8, L_WT = 2, L_U0T = 10, L_BHT2 = 11 };
constexpr int TOT_OFF = 8 * CB;
constexpr int CONV_OFF = 14 * CB;

__device__ __forceinline__ float rl(float v, int l) { return __builtin_bit_cast(float, __builtin_amdgcn_readlane(__builtin_bit_cast(int, v), l)); }
__device__ __forceinline__ float wsum(float v) {
    v += dpp_f(v, 0); v += dpp_f(v, 1); v += dpp_f(v, 2); v += dpp_f(v, 3);
    return (rl(v, 0) + rl(v, 16)) + (rl(v, 32) + rl(v, 48));
}
__device__ __forceinline__ unsigned short bf1(float x) { return (unsigned short)(cvt_pk_bf16(x, 0.f) & 0xffffu); }
__device__ __forceinline__ float bf2f(unsigned short h) { return __builtin_bit_cast(float, (unsigned)h << 16); }

__device__ __forceinline__ void mm(const LAS unsigned char* Ab, const LAS unsigned char* Bb, int rt, int ct0, int lr, int q, f32x4 (&acc)[2]) {
    const LAS unsigned char* ap = Ab + (16 * rt + lr) * CST + q * 16;
    const bf16x8 a0 = *(const LAS bf16x8*)ap, a1 = *(const LAS bf16x8*)(ap + 64);
#pragma unroll
    for (int c = 0; c < 2; ++c) { const LAS unsigned char* bp = Bb + (16 * (ct0 + c) + lr) * CST + q * 16;
        const bf16x8 b0 = *(const LAS bf16x8*)bp, b1 = *(const LAS bf16x8*)(bp + 64);
        acc[c] = __builtin_amdgcn_mfma_f32_16x16x32_bf16(a0, b0, acc[c], 0, 0, 0);
        acc[c] = __builtin_amdgcn_mfma_f32_16x16x32_bf16(a1, b1, acc[c], 0, 0, 0); }
}
__device__ __forceinline__ void ldf(bf16x8 (&f)[2], const LAS unsigned char* buf, int tile, int lr, int q) {
    const LAS unsigned char* p = buf + (16 * tile + lr) * CST + q * 16; f[0] = *(const LAS bf16x8*)p; f[1] = *(const LAS bf16x8*)(p + 64);
}
__device__ __forceinline__ f32x4 mma(const bf16x8 (&a)[2], const bf16x8 (&b)[2], f32x4 acc) {
    acc = __builtin_amdgcn_mfma_f32_16x16x32_bf16(a[0], b[0], acc, 0, 0, 0); return __builtin_amdgcn_mfma_f32_16x16x32_bf16(a[1], b[1], acc, 0, 0, 0);
}
__device__ __forceinline__ void wr_rm(LAS unsigned char* buf, int rt, int ct, int lr, int q, f32x4 v) {
#pragma unroll
    for (int r = 0; r < 4; ++r) *(LAS unsigned short*)(buf + (16 * rt + 4 * q + r) * CST + (16 * ct + lr) * 2) = bf1(v[r]);
}
__device__ __forceinline__ void wr_t(LAS unsigned char* buf, int rt, int ct, int lr, int q, f32x4 v) {
    *(LAS u32x2*)(buf + (16 * ct + lr) * CST + (16 * rt + 4 * q) * 2) = (u32x2){cvt_pk_bf16(v[0], v[1]), cvt_pk_bf16(v[2], v[3])};
}
__device__ __forceinline__ f32x4 mask_tile(f32x4 v, int rt, int ct, int lr, int q, bool incl) {
    const int col = 16 * ct + lr;
#pragma unroll
    for (int r = 0; r < 4; ++r) { const int row = 16 * rt + 4 * q + r; const bool keep = incl ? (col <= row) : (col < row); v[r] = keep ? v[r] : 0.f; }
    return v;
}

__device__ __forceinline__ int unit_of(int it) { return (it % RH) * NCHUNK + it / RH; }
struct Raw { float r[8], k[8], v[8], w[8], a[8]; };
__device__ __forceinline__ void load_raw(Raw& R, const bf16_t* r, const bf16_t* k, const bf16_t* v, const float* wld, const bf16_t* a, int unit, int wid, int lane) {
    const int hd = unit / NCHUNK, n = unit % NCHUNK;
#pragma unroll
    for (int j = 0; j < 8; ++j) { const size_t o = (size_t)(n * 64 + wid * 8 + j) * D + hd * RN + lane;
        R.r[j] = bf2f(r[o]); R.k[j] = bf2f(k[o]); R.v[j] = bf2f(v[o]); R.w[j] = (float)((const _Float16*)wld)[o]; R.a[j] = bf2f(a[o]); }
}

__device__ __forceinline__ void phase_c1(const bf16_t* r, const bf16_t* k, const bf16_t* v, const float* wld, const bf16_t* a, const float* k_k, const float* k_a, const float* r_k,
                                         bf16_t* CW, bf16_t* CBH, bf16_t* CR, bf16_t* CARB, bf16_t* CU0, bf16_t* CKV, bf16_t* CY0, float* CGC, float* BS,
                                         LAS unsigned char* lds, int bx, int G, int tid, KP kp, int l) {
    const int lane = tid & 63, wid = __builtin_amdgcn_readfirstlane(tid >> 6), lr = lane & 15, q = lane >> 4;
    const int rt = wid >> 1, ct0 = 2 * (wid & 1);
    LAS float* tot = (LAS float*)(lds + TOT_OFF);
    LAS unsigned* cscr = (LAS unsigned*)(lds + CONV_OFF + wid * CONV_SCR);
    const int gw = bx * 8 + wid, NGW = G * 8, cnt_ = RIDE ? c1_conv_split(l, G) : 0, CR_ = (cnt_ + NGW - 1) / NGW, NS_ = 2 * (NUNIT / G), CRc = CR_ < NS_ ? CR_ : NS_;
    f32x4 cv[8]; int cpend = -1, cslot = 0, cacc = 0, crd = 0;
#define C1_CONV_HOOK() do { \
        if (cpend >= 0) { const ConvD d_ = c1_conv_desc(kp, l, cpend); conv_finish(cv, d_.WT, d_.ldt, d_.sc, d_.smode, cscr, lane); cpend = -1; } \
        if (cslot < NS_) { cacc += CRc; if (cacc >= NS_) { cacc -= NS_; const int T_ = crd * NGW + gw; ++crd; \
            if (T_ < cnt_) { const ConvD d_ = c1_conv_desc(kp, l, T_); conv_issue(cv, d_.W, d_.ldw, lane, d_.smode == 3); cpend = T_; } } } \
        ++cslot; } while (0)
#define LB(i) (lds + (i) * CB)
#define C1_BAR() do { asm volatile("s_waitcnt lgkmcnt(0)" ::: "memory"); __builtin_amdgcn_s_barrier(); asm volatile("" ::: "memory"); } while (0)
    Raw R;
    if (bx < NUNIT) load_raw(R, r, k, v, wld, a, unit_of(bx), wid, lane);
    for (int it_ = bx; it_ < NUNIT; it_ += G) { const int unit = unit_of(it_);
        const int hd = unit / NCHUNK, n = unit % NCHUNK, ch = hd * RN + lane;
        const float kkc = k_k[ch], kac = k_a[ch], rkc = r_k[ch];
        float cl[8]; float run = 0.f;
#pragma unroll
        for (int j = 0; j < 8; ++j) { run += R.w[j] * LOG2E; cl[j] = run; }
        tot[wid * 64 + lane] = run;
        C1_BAR();
        float base = 0.f, clC = 0.f;
#pragma unroll
        for (int w = 0; w < 8; ++w) { const float t_ = tot[w * 64 + lane]; clC += t_; base += (w < wid) ? t_ : 0.f; }
        float atT[8], khT[8], bhT[8]; u32x4 bhP;
#pragma unroll
        for (int j = 0; j < 8; ++j) {
            const float c_ = cl[j] + base;
            const float kkv = R.k[j] * kkc; const float ss = wsum(kkv * kkv); const float kkn = kkv * (1.0f / fmaxf(sqrtf(ss), 1e-12f));
            const float b_ = kkn * R.a[j], kp = R.k[j] * (1.0f + (R.a[j] - 1.0f) * kac);
            const float bon = wsum(R.r[j] * kp * rkc);
            if (lane == 0) BS[(size_t)(n * 64 + wid * 8 + j) * RH + hd] = bon;
            const float e_m1 = __builtin_amdgcn_exp2f(c_ - R.w[j] * LOG2E), e_n = __builtin_amdgcn_exp2f(-c_), e_p = __builtin_amdgcn_exp2f(c_), e_c = __builtin_amdgcn_exp2f(clC - c_);
            const float at = -kkn * e_m1; atT[j] = at; khT[j] = kp * e_c; bhT[j] = b_ * e_c;
            const int ro = (wid * 8 + j) * CST + lane * 2;
            *(LAS unsigned short*)(LB(L_A) + ro) = bf1(at);
            *(LAS unsigned short*)(LB(L_B) + ro) = bf1(b_ * e_n);
            *(LAS unsigned short*)(LB(L_K) + ro) = bf1(kp * e_n);
            *(LAS unsigned short*)(LB(L_R) + ro) = bf1(R.r[j] * e_p);
        }
        {
            const int to = lane * CST + wid * 16;
            *(LAS u32x4*)(LB(L_AT) + to) = (u32x4){cvt_pk_bf16(atT[0], atT[1]), cvt_pk_bf16(atT[2], atT[3]), cvt_pk_bf16(atT[4], atT[5]), cvt_pk_bf16(atT[6], atT[7])};
            *(LAS u32x4*)(LB(L_VT) + to) = (u32x4){cvt_pk_bf16(R.v[0], R.v[1]), cvt_pk_bf16(R.v[2], R.v[3]), cvt_pk_bf16(R.v[4], R.v[5]), cvt_pk_bf16(R.v[6], R.v[7])};
            *(LAS u32x4*)(LB(L_KHT) + to) = (u32x4){cvt_pk_bf16(khT[0], khT[1]), cvt_pk_bf16(khT[2], khT[3]), cvt_pk_bf16(khT[4], khT[5]), cvt_pk_bf16(khT[6], khT[7])};
            bhP = (u32x4){cvt_pk_bf16(bhT[0], bhT[1]), cvt_pk_bf16(bhT[2], bhT[3]), cvt_pk_bf16(bhT[4], bhT[5]), cvt_pk_bf16(bhT[6], bhT[7])};
            if (wid == 0) CGC[(size_t)unit * 64 + lane] = __builtin_amdgcn_exp2f(clC);
        }
        C1_BAR();
        C1_CONV_HOOK();
        if (it_ + G < NUNIT) load_raw(R, r, k, v, wld, a, unit_of(it_ + G), wid, lane);
        f32x4 nreg[2], preg[2];
        {
            bf16x8 fA[2], fR[2], fB[2][2], fK[2][2];
            ldf(fA, LB(L_A), rt, lr, q); ldf(fR, LB(L_R), rt, lr, q);
#pragma unroll
            for (int c = 0; c < 2; ++c) { ldf(fB[c], LB(L_B), ct0 + c, lr, q); ldf(fK[c], LB(L_K), ct0 + c, lr, q); }
            const f32x4 z4 = (f32x4){0.f, 0.f, 0.f, 0.f};
#pragma unroll
            for (int c = 0; c < 2; ++c) { const f32x4 m = mask_tile(mma(fA, fB[c], z4), rt, ct0 + c, lr, q, false); nreg[c] = m; preg[c] = m;
                wr_rm(LB(L_P0), rt, ct0 + c, lr, q, m); wr_t(LB(L_PT0), rt, ct0 + c, lr, q, m); wr_t(LB(L_NT0), rt, ct0 + c, lr, q, m); }
#pragma unroll
            for (int c = 0; c < 2; ++c) wr_rm(LB(L_AAK), rt, ct0 + c, lr, q, mask_tile(mma(fA, fK[c], z4), rt, ct0 + c, lr, q, false));
#pragma unroll
            for (int c = 0; c < 2; ++c) wr_rm(LB(L_ARB), rt, ct0 + c, lr, q, mask_tile(mma(fR, fB[c], z4), rt, ct0 + c, lr, q, true));
#pragma unroll
            for (int c = 0; c < 2; ++c) wr_rm(LB(L_ARK), rt, ct0 + c, lr, q, mask_tile(mma(fR, fK[c], z4), rt, ct0 + c, lr, q, true));
        }
        C1_BAR();
        {
            f32x4 acc[2]; acc[0] = acc[1] = (f32x4){0.f, 0.f, 0.f, 0.f}; mm(LB(L_P0), LB(L_PT0), rt, ct0, lr, q, acc);
#pragma unroll
            for (int c = 0; c < 2; ++c) { preg[c] = acc[c]; wr_rm(LB(L_P1), rt, ct0 + c, lr, q, acc[c]); wr_t(LB(L_PT1), rt, ct0 + c, lr, q, acc[c]); }
        }
        C1_BAR();
#pragma unroll
        for (int i = 1; i <= 4; ++i) {
            LAS unsigned char* Pc = (i & 1) ? LB(L_P1) : LB(L_P0); LAS unsigned char* PTc = (i & 1) ? LB(L_PT1) : LB(L_PT0);
            LAS unsigned char* NTp = (i & 1) ? LB(L_NT0) : LB(L_NT1); LAS unsigned char* NTn = (i & 1) ? LB(L_NT1) : LB(L_NT0);
            LAS unsigned char* Pn = (i & 1) ? LB(L_P0) : LB(L_P1); LAS unsigned char* PTn = (i & 1) ? LB(L_PT0) : LB(L_PT1);
            bf16x8 fP[2], fN[2][2], fT[2][2]; ldf(fP, Pc, rt, lr, q);
#pragma unroll
            for (int c = 0; c < 2; ++c) { ldf(fN[c], NTp, ct0 + c, lr, q); ldf(fT[c], PTc, ct0 + c, lr, q); }
            f32x4 acc[2], ac2[2];
#pragma unroll
            for (int c = 0; c < 2; ++c) { acc[c] = mma(fP, fN[c], (f32x4){0.f, 0.f, 0.f, 0.f}); ac2[c] = mma(fP, fT[c], (f32x4){0.f, 0.f, 0.f, 0.f}); }
#pragma unroll
            for (int c = 0; c < 2; ++c) { nreg[c] = nreg[c] + preg[c] + acc[c]; wr_t(NTn, rt, ct0 + c, lr, q, nreg[c]);
                preg[c] = ac2[c]; wr_rm(Pn, rt, ct0 + c, lr, q, ac2[c]); wr_t(PTn, rt, ct0 + c, lr, q, ac2[c]); }
            C1_BAR();
        }
        C1_CONV_HOOK();
        f32x4 x1[2];
        {
            f32x4 acc[2]; acc[0] = acc[1] = (f32x4){0.f, 0.f, 0.f, 0.f}; mm(LB(L_P1), LB(L_NT0), rt, ct0, lr, q, acc);
#pragma unroll
            for (int c = 0; c < 2; ++c) { nreg[c] = nreg[c] + preg[c] + acc[c]; wr_rm(LB(L_N), rt, ct0 + c, lr, q, nreg[c]); }
            bf16x8 fV[2][2], fAk[2]; ldf(fAk, LB(L_AAK), rt, lr, q);
#pragma unroll
            for (int c = 0; c < 2; ++c) ldf(fV[c], LB(L_VT), ct0 + c, lr, q);
#pragma unroll
            for (int c = 0; c < 2; ++c) x1[c] = mma(fAk, fV[c], (f32x4){0.f, 0.f, 0.f, 0.f});
#pragma unroll
            for (int c = 0; c < 2; ++c) wr_t(LB(L_X1T), rt, ct0 + c, lr, q, x1[c]);
        }
        C1_BAR();
        {
            mm(LB(L_N), LB(L_X1T), rt, ct0, lr, q, x1);
#pragma unroll
            for (int c = 0; c < 2; ++c) wr_t(LB(L_U0T), rt, ct0 + c, lr, q, x1[c]);
            f32x4 acc[2];
#pragma unroll
            for (int c = 0; c < 2; ++c) { const u32x2 w_ = *(const LAS u32x2*)(LB(L_A) + (16 * (ct0 + c) + lr) * CST + (16 * rt + 4 * q) * 2);
                acc[c] = (f32x4){__builtin_bit_cast(float, w_.x << 16), __builtin_bit_cast(float, w_.x & 0xffff0000u), __builtin_bit_cast(float, w_.y << 16), __builtin_bit_cast(float, w_.y & 0xffff0000u)}; }
            mm(LB(L_AT), LB(L_N), rt, ct0, lr, q, acc);
#pragma unroll
            for (int c = 0; c < 2; ++c) wr_rm(LB(L_WT), rt, ct0 + c, lr, q, acc[c]);
            *(LAS u32x4*)(LB(L_BHT2) + lane * CST + wid * 16) = bhP;
        }
        C1_BAR();
        {
            int lr_ = lr, q_ = q, rt_ = rt, ct_ = ct0; asm volatile("" : "+v"(lr_), "+v"(q_), "+s"(rt_), "+s"(ct_));
            f32x4 acc[2];
#pragma unroll
            for (int c = 0; c < 2; ++c) { const u32x2 w_ = *(const LAS u32x2*)(LB(L_R) + (16 * (ct_ + c) + lr_) * CST + (16 * rt_ + 4 * q_) * 2);
                acc[c] = (f32x4){__builtin_bit_cast(float, w_.x << 16), __builtin_bit_cast(float, w_.x & 0xffff0000u), __builtin_bit_cast(float, w_.y << 16), __builtin_bit_cast(float, w_.y & 0xffff0000u)}; }
            mm(LB(L_WT), LB(L_ARB), rt_, ct_, lr_, q_, acc);
#pragma unroll
            for (int c = 0; c < 2; ++c) *(u32x2*)((unsigned char*)CR + (size_t)unit * 8192 + (16 * (ct_ + c) + lr_) * 128 + (16 * rt_ + 4 * q_) * 2) = (u32x2){cvt_pk_bf16(acc[c][0], acc[c][1]), cvt_pk_bf16(acc[c][2], acc[c][3])};
            f32x4 y0a[2]; y0a[0] = y0a[1] = (f32x4){0.f, 0.f, 0.f, 0.f};
            mm(LB(L_VT), LB(L_ARK), rt_, ct_, lr_, q_, y0a); mm(LB(L_U0T), LB(L_ARB), rt_, ct_, lr_, q_, y0a);
#pragma unroll
            for (int c = 0; c < 2; ++c) *(u32x2*)(CY0 + (size_t)unit * 4096 + (16 * (ct_ + c) + lr_) * 64 + 16 * rt_ + 4 * q_) = (u32x2){cvt_pk_bf16(y0a[c][0], y0a[c][1]), cvt_pk_bf16(y0a[c][2], y0a[c][3])};
            acc[0] = acc[1] = (f32x4){0.f, 0.f, 0.f, 0.f}; mm(LB(L_WT), LB(L_BHT2), rt_, ct_, lr_, q_, acc);
#pragma unroll
            for (int c = 0; c < 2; ++c) *(u32x2*)((unsigned char*)CW + (size_t)unit * 8192 + (16 * (ct_ + c) + lr_) * 128 + (16 * rt_ + 4 * q_) * 2) = (u32x2){cvt_pk_bf16(acc[c][0], acc[c][1]), cvt_pk_bf16(acc[c][2], acc[c][3])};
            acc[0] = acc[1] = (f32x4){0.f, 0.f, 0.f, 0.f}; mm(LB(L_KHT), LB(L_VT), rt_, ct_, lr_, q_, acc); mm(LB(L_BHT2), LB(L_U0T), rt_, ct_, lr_, q_, acc);
#pragma unroll
            for (int c = 0; c < 2; ++c) *(u32x2*)(CKV + (size_t)unit * 4096 + (16 * (ct_ + c) + lr_) * 64 + 16 * rt_ + 4 * q_) = (u32x2){cvt_pk_bf16(acc[c][0], acc[c][1]), cvt_pk_bf16(acc[c][2], acc[c][3])};
        }
        C1_BAR();
    }
    if (cpend >= 0) { const ConvD d_ = c1_conv_desc(kp, l, cpend); conv_finish(cv, d_.WT, d_.ldt, d_.sc, d_.smode, cscr, lane); }
    for (int rd = CRc; rd < CR_; ++rd) { const int T_ = rd * NGW + gw;
        if (T_ < cnt_) { const ConvD d_ = c1_conv_desc(kp, l, T_); conv_issue(cv, d_.W, d_.ldw, lane, d_.smode == 3); conv_finish(cv, d_.WT, d_.ldt, d_.sc, d_.smode, cscr, lane); } }
#undef C1_CONV_HOOK
#undef LB
#undef C1_BAR
}

constexpr int C2_SLOT = 21504, C2_W = 0, C2_BH = 8192, C2_U0 = 16384, C2_KV = 18432, C2_GC = 20480, C2_NSLOT = 7;
__device__ __forceinline__ void c2_issue(const unsigned char* CW, const unsigned char* CBH, const unsigned char* CU0, const unsigned char* CKV, const unsigned char* CGC,
                                         LAS unsigned char* slot, int unit, int vs, int wid, int lane) {
    if (wid >= 1 && wid <= 2) { const unsigned char* src = CW + (size_t)unit * 8192; LAS unsigned char* dst = slot + C2_W; (void)CBH; (void)CU0;
        const int u0 = ((wid - 1) & 1) * 4; const int so = (lane >> 3) * 128 + (((lane & 7) ^ (lane >> 3)) << 4);
#pragma unroll
        for (int i = 0; i < 4; ++i) __builtin_amdgcn_global_load_lds((const unsigned*)(src + (u0 + i) * 1024 + so), (LAS unsigned*)(dst + (u0 + i) * 1024), 16, 0, 0);
    } else if (wid == 5) {
        __builtin_amdgcn_global_load_lds((const unsigned*)(CGC + (size_t)unit * 256 + lane * 16), (LAS unsigned*)(slot + C2_GC), 16, 0, 0);
    } else if (wid == 6) { const unsigned char* src = CKV + (size_t)unit * 8192 + vs * 2048; const int so = (lane >> 3) * 128 + (((lane & 7) ^ (lane >> 3)) << 4);
#pragma unroll
        for (int i = 0; i < 2; ++i) __builtin_amdgcn_global_load_lds((const unsigned*)(src + i * 1024 + so), (LAS unsigned*)(slot + C2_KV + i * 1024), 16, 0, 0);
    }
}
__device__ __forceinline__ void phase_c2(const bf16_t* CW, const bf16_t* CBH, const bf16_t* CU0, const bf16_t* CKV, const float* CGC, bf16_t* CUT, bf16_t* CS0,
                                         LAS unsigned char* lds, int task, int tid) {
    const int lane = tid & 63, wid = __builtin_amdgcn_readfirstlane(tid >> 6), lr = lane & 15, q = lane >> 4;
    const int hd = task >> 2, vs = task & 3, ubase = hd * NCHUNK;
    const unsigned char* pW = (const unsigned char*)CW; const unsigned char* pBH = (const unsigned char*)CBH; const unsigned char* pU0 = (const unsigned char*)CU0;
    const unsigned char* pKV = (const unsigned char*)CKV; const unsigned char* pGC = (const unsigned char*)CGC;
#define C2_WAITV() do { if (wid >= 1 && wid <= 2) asm volatile("s_waitcnt vmcnt(20)" ::: "memory"); else if (wid == 5) asm volatile("s_waitcnt vmcnt(5)" ::: "memory"); \
                        else if (wid == 6) asm volatile("s_waitcnt vmcnt(10)" ::: "memory"); } while (0)
#pragma unroll
    for (int m = 0; m < C2_NSLOT - 1; ++m) c2_issue(pW, pBH, pU0, pKV, pGC, lds + m * C2_SLOT, ubase + m, vs, wid, lane);
    f32x4 sreg[4]; bf16x8 sfrag[2];
#pragma unroll
    for (int i = 0; i < 4; ++i) sreg[i] = (f32x4){0.f, 0.f, 0.f, 0.f};
    sfrag[0] = sfrag[1] = (bf16x8){0, 0, 0, 0, 0, 0, 0, 0};
    for (int n = 0; n < NCHUNK; ++n) {
        C2_WAITV();
        asm volatile("s_waitcnt lgkmcnt(0)" ::: "memory");
        __builtin_amdgcn_s_barrier();
        asm volatile("" ::: "memory");
        { const int m = (n + 6 < NCHUNK) ? n + 6 : NCHUNK - 1; c2_issue(pW, pBH, pU0, pKV, pGC, lds + ((n + 6) % C2_NSLOT) * C2_SLOT, ubase + m, vs, wid, lane); }
        if (wid == 0) {
            const LAS unsigned char* sl = lds + (n % C2_NSLOT) * C2_SLOT;
            const size_t uo = (size_t)(ubase + n) * 8192 + (size_t)(16 * vs + lr) * 128;
            bf16x8 mf[4][2]; f32x4 kvv[4], gcv[4];
#pragma unroll
            for (int ct = 0; ct < 4; ++ct) { const int row = 16 * ct + lr;
                gcv[ct] = *(const LAS f32x4*)(sl + C2_GC + (16 * ct + 4 * q) * 4);
                { const int chn = 2 * ct + (q >> 1); const u32x2 w_ = *(const LAS u32x2*)(sl + C2_KV + lr * 128 + ((chn ^ (lr & 7)) << 4) + (q & 1) * 8);
                  kvv[ct] = (f32x4){__builtin_bit_cast(float, w_.x << 16), __builtin_bit_cast(float, w_.x & 0xffff0000u), __builtin_bit_cast(float, w_.y << 16), __builtin_bit_cast(float, w_.y & 0xffff0000u)}; }
#pragma unroll
                for (int g = 0; g < 2; ++g) { const int c0 = 4 * g + (q >> 1);
                    const u32x2 lo = *(const LAS u32x2*)(sl + C2_W + row * 128 + ((c0 ^ (row & 7)) << 4) + (q & 1) * 8), hi = *(const LAS u32x2*)(sl + C2_W + row * 128 + (((c0 + 2) ^ (row & 7)) << 4) + (q & 1) * 8);
                    mf[ct][g] = __builtin_bit_cast(bf16x8, (u32x4){lo.x, lo.y, hi.x, hi.y}); } }
#pragma unroll
            for (int g = 0; g < 2; ++g) { const u32x4 w_ = __builtin_bit_cast(u32x4, sfrag[g]);
                *(u32x2*)((unsigned char*)CS0 + uo + (32 * g + 4 * q) * 2) = (u32x2){w_.x, w_.y}; *(u32x2*)((unsigned char*)CS0 + uo + (32 * g + 16 + 4 * q) * 2) = (u32x2){w_.z, w_.w}; }
#pragma unroll
            for (int ct = 0; ct < 4; ++ct) {
                f32x4 acc = sreg[ct] * gcv[ct] + kvv[ct];
#pragma unroll
                for (int g = 0; g < 2; ++g) acc = __builtin_amdgcn_mfma_f32_16x16x32_bf16(mf[ct][g], sfrag[g], acc, 0, 0, 0);
                sreg[ct] = acc;
            }
            (void)CUT;
#pragma unroll
            for (int g = 0; g < 2; ++g) sfrag[g] = __builtin_bit_cast(bf16x8, (u32x4){cvt_pk_bf16(sreg[2 * g][0], sreg[2 * g][1]), cvt_pk_bf16(sreg[2 * g][2], sreg[2 * g][3]),
                                                                                       cvt_pk_bf16(sreg[2 * g + 1][0], sreg[2 * g + 1][1]), cvt_pk_bf16(sreg[2 * g + 1][2], sreg[2 * g + 1][3])});
        }
    }
#undef C2_WAITV
    asm volatile("s_waitcnt vmcnt(0)" ::: "memory");
    __syncthreads();
}

__device__ __forceinline__ void phase_c3(const bf16_t* CS0, const bf16_t* CUT, const bf16_t* CR, const bf16_t* CARB, const bf16_t* CY0, const float* BS, const bf16_t* v, const bf16_t* g,
                                         const float* lnw, const float* lnb, bf16_t* yg, int bx, int G, int tid) {
    const int lane = tid & 63, wid = __builtin_amdgcn_readfirstlane(tid >> 6), lr = lane & 15, q = lane >> 4, tt = wid & 3;
    for (int it_ = bx * 2 + (wid >> 2); it_ < NUNIT; it_ += 2 * G) { const int unit = unit_of(it_);
        const int hd = unit / NCHUNK, n = unit % NCHUNK, t = n * 64 + 16 * tt + lr;
        const size_t ub = (size_t)unit * 4096;
        bf16x8 br[2]; (void)CUT; (void)CARB;
#pragma unroll
        for (int ks = 0; ks < 2; ++ks) br[ks] = *(const bf16x8*)(CR + ub + (16 * tt + lr) * 64 + 32 * ks + 8 * q);
        f32x4 acc[4];
#pragma unroll
        for (int vt = 0; vt < 4; ++vt) {
            { const u32x2 w_ = *(const u32x2*)(CY0 + ub + (16 * tt + lr) * 64 + 16 * vt + 4 * q);
              acc[vt] = (f32x4){__builtin_bit_cast(float, w_.x << 16), __builtin_bit_cast(float, w_.x & 0xffff0000u), __builtin_bit_cast(float, w_.y << 16), __builtin_bit_cast(float, w_.y & 0xffff0000u)}; }
#pragma unroll
            for (int ks = 0; ks < 2; ++ks) {
                const bf16x8 as = *(const bf16x8*)(CS0 + ub + (16 * vt + lr) * 64 + 32 * ks + 8 * q);
                acc[vt] = __builtin_amdgcn_mfma_f32_16x16x32_bf16(as, br[ks], acc[vt], 0, 0, 0);
            }
        }
        float s = 0.f;
#pragma unroll
        for (int vt = 0; vt < 4; ++vt) s += (acc[vt][0] + acc[vt][1]) + (acc[vt][2] + acc[vt][3]);
        s += __shfl_xor(s, 16); s += __shfl_xor(s, 32);
        const float mu = s * (1.0f / RN);
        float s2 = 0.f;
#pragma unroll
        for (int vt = 0; vt < 4; ++vt) { acc[vt] = acc[vt] - mu; s2 += (acc[vt][0] * acc[vt][0] + acc[vt][1] * acc[vt][1]) + (acc[vt][2] * acc[vt][2] + acc[vt][3] * acc[vt][3]); }
        s2 += __shfl_xor(s2, 16); s2 += __shfl_xor(s2, 32);
        const float rstd = rsqrtf(s2 * (1.0f / RN) + LNX_EPS);
        const float bon = BS[(size_t)t * RH + hd];
#pragma unroll
        for (int vt = 0; vt < 4; ++vt) { const int c = hd * RN + 16 * vt + 4 * q; const size_t o = (size_t)t * D + c;
            const f32x4 w_ = *(const f32x4*)(lnw + c), b_ = *(const f32x4*)(lnb + c); const u32x2 vw = *(const u32x2*)(v + o); const u32x2 gg = *(const u32x2*)(g + o);
            const f32x4 vv = (f32x4){__builtin_bit_cast(float, vw.x << 16), __builtin_bit_cast(float, vw.x & 0xffff0000u), __builtin_bit_cast(float, vw.y << 16), __builtin_bit_cast(float, vw.y & 0xffff0000u)};
            const f32x4 gv = (f32x4){__builtin_bit_cast(float, gg.x << 16), __builtin_bit_cast(float, gg.x & 0xffff0000u), __builtin_bit_cast(float, gg.y << 16), __builtin_bit_cast(float, gg.y & 0xffff0000u)};
            const f32x4 o_ = (acc[vt] * rstd * w_ + b_ + vv * bon) * gv;
            *(u32x2*)(yg + o) = (u32x2){cvt_pk_bf16(o_[0], o_[1]), cvt_pk_bf16(o_[2], o_[3])}; }
    }
}
}

constexpr int ATT_KS = 272, ATT_VS = 136, ATT_KB = 64 * ATT_KS, ATT_VB = 128 * ATT_VS, ATT_BUF = ATT_KB + ATT_VB + 256;
constexpr int CW_KMAX = 8192;
constexpr float ATT_SKIP = 160.f;
constexpr int AT_K = 0, AT_V = 16384, AT_C = 32768, AT_SLOT = 33792;
__device__ __forceinline__ void att_issue(const bf16_t* kb_, const bf16_t* vt_, const float* cs2, LAS unsigned char* slot, int hd, int kt, int wid, int lane) {
#pragma unroll
    for (int j = 0; j < 2; ++j) { const int p = 2 * wid + j, row = 4 * p + (lane >> 4);
        __builtin_amdgcn_global_load_lds((const unsigned*)((const unsigned char*)(kb_ + (size_t)(kt * 64 + row) * D + hd * FD) + (((lane & 15) ^ (row & 15)) << 4)), (LAS unsigned*)(slot + AT_K + p * 1024), 16, 0, 0); }
#pragma unroll
    for (int j = 0; j < 2; ++j) { const int p = 2 * wid + j, row = 8 * p + (lane >> 3);
        __builtin_amdgcn_global_load_lds((const unsigned*)((const unsigned char*)(vt_ + (size_t)(hd * FD + row) * S + kt * 64) + (((lane & 7) ^ ((row >> 1) & 7)) << 4)), (LAS unsigned*)(slot + AT_V + p * 1024), 16, 0, 0); }
    if (wid == 0) __builtin_amdgcn_global_load_lds((const unsigned*)((const unsigned char*)(cs2 + (size_t)hd * S + kt * 64) + lane * 16), (LAS unsigned*)(slot + AT_C), 16, 0, 0);
}
__device__ __forceinline__ void attn_unit(const bf16_t* qb_, const bf16_t* kb_, const bf16_t* vt_, const float* cs2, const unsigned* kmaxw, bf16_t* ob_, LAS unsigned char* lds,
                                          volatile LAS unsigned* donecnt, int hd, int qblk, int tid) {
    const int lane = tid & 63, wid = __builtin_amdgcn_readfirstlane(tid >> 6), ql = lane & 31, hh = lane >> 5;
    const int q0 = qblk * 256 + wid * 32, qrow = q0 + ql;
    const int ntile = qblk * 4 + 4;
    const int my_last = (q0 + 31) >> 6;
#define AT_WAITV(n_) do { if (wid == 0) asm volatile("s_waitcnt vmcnt(%0)" :: "n"(5 * (n_)) : "memory"); else asm volatile("s_waitcnt vmcnt(%0)" :: "n"(4 * (n_)) : "memory"); } while (0)
    if (tid == 0) *donecnt = 0u;
    att_issue(kb_, vt_, cs2, lds, hd, ntile - 1, wid, lane);
    att_issue(kb_, vt_, cs2, lds + AT_SLOT, hd, (ntile - 2 > 0) ? ntile - 2 : 0, wid, lane);
    int koff_[8], voff_[4];
#pragma unroll
    for (int ks = 0; ks < 8; ++ks) koff_[ks] = ql * 256 + (((2 * ks + hh) ^ (ql & 15)) << 4);
#pragma unroll
    for (int s4 = 0; s4 < 4; ++s4) voff_[s4] = ql * 128 + (((2 * s4 + hh) ^ ((ql >> 1) & 7)) << 4);
    bf16x8 qf[8];
#pragma unroll
    for (int ks = 0; ks < 8; ++ks) qf[ks] = *(const bf16x8*)(qb_ + (size_t)qrow * D + hd * FD + ks * 16 + hh * 8);
    float qs = 0.f;
#pragma unroll
    for (int ks = 0; ks < 8; ++ks)
#pragma unroll
        for (int j = 0; j < 8; ++j) { const float v = __builtin_bit_cast(float, (unsigned)(unsigned short)qf[ks][j] << 16); qs += v * v; }
    qs += __shfl_xor(qs, 32);
    float kmax2 = 0.f;
#pragma unroll
    for (int p = 0; p < 4; ++p) kmax2 += __builtin_bit_cast(float, __hip_atomic_load(kmaxw + hd * 4 + p, __ATOMIC_RELAXED, __HIP_MEMORY_SCOPE_AGENT));
    const float kmax = sqrtf(kmax2);
    const float qk_bound = sqrtf(qs) * kmax * 1.01f + 1.0f;
    f32x16 ot[4];
#pragma unroll
    for (int i = 0; i < 4; ++i)
#pragma unroll
        for (int j = 0; j < 16; ++j) ot[i][j] = 0.f;
    float m_run = -1e30f, l_run = 0.f;
    bool done = false;
    int it = 0;
    for (int kt = ntile - 1; kt >= 0; --kt, ++it) {
        AT_WAITV(1);
        asm volatile("s_waitcnt lgkmcnt(0)" ::: "memory");
        __builtin_amdgcn_s_barrier();
        asm volatile("" ::: "memory");
        if (*donecnt == 8u) break;
        { const int kn = (kt - 2 > 0) ? kt - 2 : 0; att_issue(kb_, vt_, cs2, lds + ((it + 2) % 3) * AT_SLOT, hd, kn, wid, lane); }
        if (kt <= my_last && !done) {
            const LAS unsigned char* kb = lds + (it % 3) * AT_SLOT; const LAS unsigned char* vb = kb + AT_V; const LAS float* cb = (const LAS float*)(kb + AT_C);
            f32x16 st[2];
            bf16x8 af[2][8]; f32x4 ckv[2][4];
#pragma unroll
            for (int kh = 0; kh < 2; ++kh) { const int row = kh * 32 + ql;
#pragma unroll
                for (int ks = 0; ks < 8; ++ks) af[kh][ks] = *(const LAS bf16x8*)(kb + koff_[ks] + kh * 8192);
#pragma unroll
                for (int g4 = 0; g4 < 4; ++g4) ckv[kh][g4] = *(const LAS f32x4*)(cb + kh * 32 + 8 * g4 + 4 * hh); }
#pragma unroll
            for (int kh = 0; kh < 2; ++kh)
#pragma unroll
                for (int g4 = 0; g4 < 4; ++g4)
#pragma unroll
                    for (int e = 0; e < 4; ++e) st[kh][g4 * 4 + e] = ckv[kh][g4][e];
#pragma unroll
            for (int ks = 0; ks < 8; ++ks)
#pragma unroll
                for (int kh = 0; kh < 2; ++kh) st[kh] = __builtin_amdgcn_mfma_f32_32x32x16_bf16(af[kh][ks], qf[ks], st[kh], 0, 0, 0);
            const bool diag = (kt * 64 + 63 > q0);
            float mloc = -__builtin_inff();
            if (diag) {
#pragma unroll
                for (int kh = 0; kh < 2; ++kh)
#pragma unroll
                    for (int g4 = 0; g4 < 4; ++g4)
#pragma unroll
                        for (int e = 0; e < 4; ++e) { const int key = kt * 64 + kh * 32 + 8 * g4 + 4 * hh + e; if (key > qrow) st[kh][g4 * 4 + e] = -__builtin_inff(); }
            }
#pragma unroll
            for (int kh = 0; kh < 2; ++kh)
#pragma unroll
                for (int j = 0; j < 16; ++j) mloc = fmaxf(mloc, st[kh][j]);
            mloc = fmaxf(mloc, __shfl_xor(mloc, 32));
            const float m_new = fmaxf(m_run, mloc);
            const float alpha = __builtin_amdgcn_exp2f(m_run - m_new);
            m_run = m_new;
            const f32x2_t nm2 = {-m_new, -m_new}; f32x2_t ps2 = {0.f, 0.f};
#pragma unroll
            for (int kh = 0; kh < 2; ++kh)
#pragma unroll
                for (int j = 0; j < 16; j += 2) { const f32x2_t d2 = (f32x2_t){st[kh][j], st[kh][j + 1]} + nm2;
                    const f32x2_t p2 = {__builtin_amdgcn_exp2f(d2[0]), __builtin_amdgcn_exp2f(d2[1])}; st[kh][j] = p2[0]; st[kh][j + 1] = p2[1]; ps2 = ps2 + p2; }
            const float ps = ps2[0] + ps2[1];
            l_run = l_run * alpha + ps;
            if (!__all(alpha == 1.0f)) {
#pragma unroll
                for (int i = 0; i < 4; ++i)
#pragma unroll
                    for (int j = 0; j < 16; ++j) ot[i][j] *= alpha;
            }
            bf16x8 vfr[2][4];
#define AT_LDV(dst, s4_) do { _Pragma("unroll") for (int db = 0; db < 4; ++db) dst[db] = *(const LAS bf16x8*)(vb + voff_[s4_] + db * 4096); } while (0)
            AT_LDV(vfr[0], 0);
#pragma unroll
            for (int s4 = 0; s4 < 4; ++s4) { const int kh = s4 >> 1, sl = s4 & 1;
                if (s4 < 3) AT_LDV(vfr[(s4 + 1) & 1], s4 + 1);
                u32x4 pw; pw.x = cvt_pk_bf16(st[kh][8 * sl + 0], st[kh][8 * sl + 1]); pw.y = cvt_pk_bf16(st[kh][8 * sl + 2], st[kh][8 * sl + 3]);
                pw.z = cvt_pk_bf16(st[kh][8 * sl + 4], st[kh][8 * sl + 5]); pw.w = cvt_pk_bf16(st[kh][8 * sl + 6], st[kh][8 * sl + 7]);
                const bf16x8 pf = __builtin_bit_cast(bf16x8, pw);
#pragma unroll
                for (int db = 0; db < 4; ++db) ot[db] = __builtin_amdgcn_mfma_f32_32x32x16_bf16(vfr[s4 & 1][db], pf, ot[db], 0, 0, 0);
            }
#undef AT_LDV
            const float ub = qk_bound + cb[0];
            if (__all(ub < m_run - ATT_SKIP)) { done = true; if (lane == 0) __hip_atomic_fetch_add((LAS unsigned*)donecnt, 1u, __ATOMIC_RELAXED, __HIP_MEMORY_SCOPE_WORKGROUP); }
        }
    }
#undef AT_WAITV
    asm volatile("s_waitcnt vmcnt(0)" ::: "memory");
    const float lt = l_run + __shfl_xor(l_run, 32);
    const float inv = 1.0f / lt;
#pragma unroll
    for (int db = 0; db < 4; ++db)
#pragma unroll
        for (int g4 = 0; g4 < 4; ++g4) { const int d = db * 32 + 8 * g4 + 4 * hh;
            u32x2 o; o.x = cvt_pk_bf16(ot[db][4 * g4 + 0] * inv, ot[db][4 * g4 + 1] * inv); o.y = cvt_pk_bf16(ot[db][4 * g4 + 2] * inv, ot[db][4 * g4 + 3] * inv);
            *(u32x2*)(ob_ + (size_t)qrow * D + hd * FD + d) = o; }
    asm volatile("s_waitcnt lgkmcnt(0)" ::: "memory");
    __builtin_amdgcn_s_barrier();
    asm volatile("" ::: "memory");
}

extern __shared__ __attribute__((aligned(16))) unsigned char lds_raw[];
#ifndef ONLY_PH
#define ONLY_PH -1
#endif
#ifndef PROBE_MASK
#define PROBE_MASK 0u
#endif
#define IN(i) ((const float*)(const GAS float*)kp[i])
#define PH_BEGIN(id) if ((ONLY_PH < 0 || ONLY_PH == (id)) && ph >= lo && ph < hi) { \
    int tid = threadIdx.x; asm volatile("" : "+v"(tid)); KP kp = kp0; asm volatile("" : "+s"(kp)); \
    LAS unsigned char* lds = (LAS unsigned char*)lds_raw; \
    const int lane = tid & 63, wave = __builtin_amdgcn_readfirstlane(tid >> 6); \
    const int G = gridDim.x, bx = blockIdx.x; \
    const int gw = bx * 8 + wave, NGW = G * 8, gtid = bx * 512 + tid, GT = G * 512; \
    unsigned char* ws = (unsigned char*)(GAS unsigned char*)kp[31]; float* X = (float*)(GAS float*)kp[30]; \
    (void)lane; (void)gw; (void)NGW; (void)gtid; (void)GT; (void)X; (void)lds; \
    bf16_t* hbuf = (bf16_t*)(ws + WS_H); bf16_t* xs = (bf16_t*)(ws + WS_XS); \
    bf16_t* Rb = (bf16_t*)(ws + WS_R); bf16_t* Kb = (bf16_t*)(ws + WS_K); \
    bf16_t* part = (bf16_t*)(ws + WS_PART); float* wld = (float*)(ws + WS_WLDEC); bf16_t* Ab = (bf16_t*)(ws + WS_A); bf16_t* Gb = (bf16_t*)(ws + WS_G); \
    bf16_t* act = (bf16_t*)(ws + WS_ACT); bf16_t* yg = (bf16_t*)(ws + WS_YG); \
    bf16_t* hf = (bf16_t*)(ws + WS_HF); bf16_t* Ub = (bf16_t*)(ws + WS_U); \
    bf16_t* hq = (bf16_t*)(ws + WS_XS); bf16_t* hk = (bf16_t*)(ws + WS_XS + 32 * MiB); \
    bf16_t* Qb = (bf16_t*)(ws + WS_Q); bf16_t* KBb = (bf16_t*)(ws + WS_KB); bf16_t* VTb = (bf16_t*)(ws + WS_VT); bf16_t* Ob = (bf16_t*)(ws + WS_O); \
    float* lf = (float*)(ws + WS_LF); float* cs2 = (float*)(ws + WS_CS); \
    (void)hbuf; (void)xs; (void)Rb; (void)Kb; (void)part; (void)wld; (void)Ab; (void)Gb; (void)act; (void)yg; (void)hf; (void)Ub; (void)hq; (void)hk; (void)Qb; (void)KBb; (void)VTb; (void)Ob; (void)lf; (void)cs2; \
    for (int rp_ = 0; rp_ < ((((unsigned)PROBE_MASK >> (id)) & 1u) ? 2 : 1); ++rp_) {
#define VB_ ((bf16_t*)(ws + (layer == 0 ? WS_VF : WS_V)))
#define VFB_ ((const bf16_t*)(ws + WS_VF))
#if MK_SPLIT
#define PH_END } } ++ph;
#else
#define PH_END } if (ph + 1 < hi) xcd_barrier(bar); } ++ph;
#endif

template <int layer> __device__ __forceinline__ void layer_body(int& ph, const int lo, const int hi, const XcdBarrier& bar, const KP kp0) {
                if (layer < 2) {
            const int l = layer;
            if constexpr (layer != 0) {
            PH_BEGIN(1)
            phase_r1((const void*)hf, true, IN(1) + (size_t)layer * D, IN(4) + (size_t)l * 6 * D, hbuf, xs, gw, NGW, lane);
            PH_END
            }
            PH_BEGIN(2)
            {
                pg8::Gemm g{xs, (const bf16_t*)(ws + WS_WRKV) + (size_t)l * 3 * D * D, D, D, D, 8, (size_t)S * D};
                pg8::StaticOrder so; so.init(S / 256, 3 * D / 256, 1, G, bx);
                pg8::Epi<pg8::EPI_BF16> E{Rb, Kb, VB_, nullptr, nullptr, D, D, 0, 1.f};
                pg8::gemm_phase(lds, g, so, E, tid);
            }
            {
                pg8::Gemm g{hbuf, (const bf16_t*)(ws + WS_WLD) + (size_t)l * LORA_N * 2 * D, D, 2 * D, 1024, 1 << 20, 0};
                pg8::StaticOrder so; so.init(S / 256, LORA_N / 256, 4, G, bx);
                pg8::Epi<pg8::EPI_BF16> E{part, nullptr, nullptr, nullptr, nullptr, LORA_N, 0, (size_t)S * LORA_N, 1.f};
                pg8::gemm_phase(lds, g, so, E, tid);
            }
            PH_END
            PH_BEGIN(3)
            phase_r3(part, act, gtid, GT);
#if !RIDE
            { LAS unsigned* scr = (LAS unsigned*)(lds + wave * 16384); f32x4 cv[8];
              for (int T_ = gw; T_ < c1_conv_ntiles(l); T_ += NGW) { const ConvD d_ = c1_conv_desc(kp, l, T_); conv_issue(cv, d_.W, d_.ldw, lane, d_.smode == 3); conv_finish(cv, d_.WT, d_.ldt, d_.sc, d_.smode, scr, lane); } }
#endif
            PH_END
            PH_BEGIN(4)
            {
                const bf16_t* wlu = (const bf16_t*)(ws + WS_WLU) + (size_t)l * 4 * D * 256;
                touch_weights(wlu, (size_t)4 * D * 256 * 2, lds, wave, gw, NGW, lane);
                pg8::StaticOrder so; so.init(S / 256, D / 256, 1, G, bx);
                { pg8::Gemm g{act, wlu, 256, 256, 256, 1 << 20, 0};
                  pg8::Epi<pg8::EPI_LW> E{wld, nullptr, nullptr, nullptr, IN(6) + (size_t)l * D, D, 0, 0, 1.f}; int tid2 = tid; asm volatile("" : "+v"(tid2)); pg8::gemm_phase(lds, g, so, E, tid2); }
                { pg8::Gemm g{act + (size_t)S * 256, wlu + (size_t)D * 256, 256, 256, 256, 1 << 20, 0};
                  pg8::Epi<pg8::EPI_LA> E{Ab, nullptr, nullptr, nullptr, IN(9) + (size_t)l * D, D, 0, 0, 1.f}; int tid2 = tid; asm volatile("" : "+v"(tid2)); pg8::gemm_phase(lds, g, so, E, tid2); }
                if (l == 1) { pg8::Gemm g{act + (size_t)2 * S * 256, wlu + (size_t)2 * D * 256, 256, 256, 256, 1 << 20, 0};
                  pg8::Epi<pg8::EPI_LV> E{VB_, nullptr, nullptr, VFB_, IN(12), D, 0, 0, 1.f}; int tid2 = tid; asm volatile("" : "+v"(tid2)); pg8::gemm_phase(lds, g, so, E, tid2); }
                { pg8::Gemm g{act + (size_t)3 * S * 256, wlu + (size_t)3 * D * 256, 256, 256, 256, 1 << 20, 0};
                  pg8::Epi<pg8::EPI_BF16> E{Gb, nullptr, nullptr, nullptr, nullptr, D, 0, 0, 1.f}; int tid2 = tid; asm volatile("" : "+v"(tid2)); pg8::gemm_phase(lds, g, so, E, tid2); }
            }
            PH_END
            PH_BEGIN(5)
            ck::phase_c1(Rb, Kb, VB_, wld, Ab, IN(17) + (size_t)l * D, IN(18) + (size_t)l * D, IN(19) + (size_t)l * D,
                         (bf16_t*)(ws + WS_CW), (bf16_t*)(ws + WS_CBH), (bf16_t*)(ws + WS_CR), (bf16_t*)(ws + WS_CARB), (bf16_t*)(ws + WS_CU0), (bf16_t*)(ws + WS_CKV), (bf16_t*)(ws + WS_CY0),
                         (float*)(ws + WS_CGC), (float*)(ws + WS_BS), lds, bx, G, tid, kp, l);
            PH_END
            PH_BEGIN(6)
            if (bx < RH * 4) ck::phase_c2((const bf16_t*)(ws + WS_CW), (const bf16_t*)(ws + WS_CBH), (const bf16_t*)(ws + WS_CU0), (const bf16_t*)(ws + WS_CKV), (const float*)(ws + WS_CGC),
                                          (bf16_t*)(ws + WS_CUT), (bf16_t*)(ws + WS_CS0), lds, bx, tid);
            else if (RIDE) {
                c1_conv_range(kp, l, c1_conv_split(l, G) + (bx - RH * 4) * 8 + wave, c1_conv_ntiles(l), (G - RH * 4) * 8, (LAS unsigned*)(lds + wave * 16384), lane);
            }
            PH_END
            PH_BEGIN(17)
            ck::phase_c3((const bf16_t*)(ws + WS_CS0), (const bf16_t*)(ws + WS_CUT), (const bf16_t*)(ws + WS_CR), (const bf16_t*)(ws + WS_CARB), (const bf16_t*)(ws + WS_CY0), (const float*)(ws + WS_BS),
                         VB_, Gb, IN(20) + (size_t)l * D, IN(21) + (size_t)l * D, yg, bx, G, tid);
            PH_END
            PH_BEGIN(7)
            {
                touch_weights((const bf16_t*)(ws + WS_WWO) + (size_t)l * D * D, (size_t)D * D * 2, lds, wave, gw, NGW, lane);
                pg8::Gemm g{yg, (const bf16_t*)(ws + WS_WWO) + (size_t)l * D * D, D, D, D, 1 << 20, 0};
                pg8::StaticOrder so; so.init(S / 256, D / 256, 1, G, bx);
                pg8::Epi<pg8::EPI_RES> E{X, nullptr, nullptr, layer == 0 ? (const void*)IN(0) : (const void*)hf, nullptr, D, 0, 0, 1.f, hf, (unsigned long long*)((unsigned*)(ws + WS_CTL) + CW_SS) + layer * S, nullptr, layer == 0 ? 1 : 3};
                pg8::gemm_phase(lds, g, so, E, tid);
            }
            PH_END
        } else {
            const int j = layer - 2;
            if (j == 0) {
            PH_BEGIN(8)
            {
                phase_f0(hf, IN(1) + (size_t)layer * D, hq, IN(23), hk, IN(24), IN(25), lf, (LAS float*)lds, gw, NGW, lane, tid);
            }
            PH_END
            }
            PH_BEGIN(9)
            if (j == 0) {
                if (bx < FH) phase_cumsum(lf, cs2, bx, (LAS double*)lds, tid);
                { pg8::Gemm g{hq, (const bf16_t*)(ws + WS_WQK), D, D, D, 8, (size_t)S * D};
                  pg8::StaticOrder so; so.init(S / 256, 2 * D / 256, 1, G, bx);
                  pg8::Epi<pg8::EPI_BF16> E{Qb, KBb, nullptr, nullptr, nullptr, D, D, 0, QK_SCALE, nullptr, nullptr, nullptr, 0, (unsigned*)(ws + WS_CTL) + CW_KMAX}; pg8::gemm_phase(lds, g, so, E, tid); }
                { pg8::Gemm g{(const bf16_t*)(ws + WS_WV), hk, D, D, D, 1 << 20, 0};
                  pg8::StaticOrder so; so.init(D / 256, S / 256, 1, G, bx);
                  pg8::Epi<pg8::EPI_BF16> E{VTb, nullptr, nullptr, nullptr, nullptr, S, 0, 0, 1.f}; E.vperm = 1; pg8::gemm_phase(lds, g, so, E, tid); }
            } else {
touch_weights((const bf16_t*)(ws + WS_WQ3), (size_t)D * D * 2, lds, wave, gw, NGW, lane);
                pg8::Gemm g{hf, (const bf16_t*)(ws + WS_WQ3), D, D, D, 1 << 20, 0};
                pg8::StaticOrder so; so.init(S / 256, D / 256, 1, G, bx);
                pg8::Epi<pg8::EPI_BF16> E{Qb, nullptr, nullptr, nullptr, nullptr, D, 0, 0, QK_SCALE, nullptr, nullptr, (const unsigned long long*)((const unsigned*)(ws + WS_CTL) + CW_SS) + 4 * S}; pg8::gemm_phase(lds, g, so, E, tid);
            }
            PH_END
            PH_BEGIN(10)
            {
                volatile LAS unsigned* dc = (volatile LAS unsigned*)(lds + MISC_OFF);
                const unsigned* kmaxw = (const unsigned*)(ws + WS_CTL) + CW_KMAX;
                for (int u = bx; u < FH * 32; u += G) { const int hd = u & 15, qb2 = u >> 4;
                    attn_unit(Qb, KBb, VTb, cs2, kmaxw, Ob, lds, dc + ((u / G) & 1), hd, qb2, tid); }
            }
            PH_END
            PH_BEGIN(11)
            {
                touch_weights((const bf16_t*)(ws + WS_WFO) + (size_t)j * D * D, (size_t)D * D * 2, lds, wave, gw, NGW, lane);
                pg8::Gemm g{Ob, (const bf16_t*)(ws + WS_WFO) + (size_t)j * D * D, D, D, D, 1 << 20, 0};
                pg8::StaticOrder so; so.init(S / 256, D / 256, 1, G, bx);
                pg8::Epi<pg8::EPI_RES> E{X, nullptr, nullptr, hf, nullptr, D, 0, 0, 1.f, hf, (unsigned long long*)((unsigned*)(ws + WS_CTL) + CW_SS) + layer * S, nullptr, 3};
                pg8::gemm_phase(lds, g, so, E, tid);
            }
            PH_END
        }
        PH_BEGIN(13)
        {
            pg8::Gemm g{hf, (const bf16_t*)(ws + (layer < 2 ? WS_WUP01 + (size_t)layer * D * FF * 2 : (layer == 2 ? WS_WUP2 : WS_WUP3))), D, D, D, 1 << 20, 0};
            pg8::StaticOrder so; so.init(S / 256, FF / 256, 1, G, bx);
            pg8::Epi<pg8::EPI_RELU2> E{Ub, nullptr, nullptr, nullptr, nullptr, FF, 0, 0, 1.f, nullptr, nullptr, (const unsigned long long*)((const unsigned*)(ws + WS_CTL) + CW_SS) + layer * S};
            E.q8 = (F8_M3_MASK >> layer) & 1;
            pg8::gemm_phase(lds, g, so, E, tid);
        }
        PH_END
        PH_BEGIN(14)
        {
            constexpr bool f8 = (F8_M3_MASK >> layer) & 1;
            pg8::Gemm g{Ub, (const bf16_t*)(ws + (layer < 2 ? WS_WDN01 + (size_t)layer * D * FF * 2 : (layer == 2 ? WS_WDN2 : WS_WDN3))), f8 ? FF / 2 : FF, f8 ? FF / 2 : FF, f8 ? FF / 2 : FF, 1 << 20, 0};
            pg8::StaticOrder so; so.init(S / 256, D / 256, 1, G, bx);
            pg8::Epi<pg8::EPI_RES> E{X, nullptr, nullptr, hf, nullptr, D, 0, 0, 1.f, (layer < 3) ? hf : nullptr, (layer == 2) ? (unsigned long long*)((unsigned*)(ws + WS_CTL) + CW_SS) + 4 * S : nullptr, nullptr, (layer < 3) ? 3 : 2};
            if constexpr (f8) { E.wamax = (const unsigned*)(ws + WS_CTL) + CW_WAMAX + layer; pg8::gemm_phase<decltype(E), true>(lds, g, so, E, tid); }
            else pg8::gemm_phase(lds, g, so, E, tid);
        }
        PH_END
    }

__global__ void __launch_bounds__(512, 2) mega(Args args) {
    const KP kp0 = (KP)__builtin_amdgcn_kernarg_segment_ptr();
    {
        volatile LAS unsigned* MISC0 = (volatile LAS unsigned*)((LAS unsigned char*)lds_raw + MISC_OFF);
        if (threadIdx.x < 16) MISC0[threadIdx.x] = 0u;
        __syncthreads();
    }
    XcdBarrier bar; bar.bar = (unsigned*)(args.ws + WS_CTL) + CW_BAR; bar.x = 0; bar.st = (volatile LAS unsigned*)((LAS unsigned char*)lds_raw + MISC_OFF) + 8;
#if !MK_SPLIT
    bar = xcd_barrier_post((unsigned*)(args.ws + WS_CTL) + CW_BAR, (volatile LAS unsigned*)((LAS unsigned char*)lds_raw + MISC_OFF) + 8);
#endif
    const int lo = args.ph_lo, hi = args.ph_hi;
    int ph = 0;
    PH_BEGIN(0)
    {
#pragma unroll
        for (int lq = 0; lq < NLAYER; ++lq) if ((F8_M3_MASK >> lq) & 1) {
            const float* wq = IN(29) + (size_t)lq * D * FF; float am = 0.f;
            for (int idx = gtid; idx < D * FF / 32; idx += GT) { const f32x4 q4 = *(const GAS f32x4*)(wq + (size_t)idx * 32); am = fmaxf(fmaxf(am, fmaxf(fabsf(q4.x), fabsf(q4.y))), fmaxf(fabsf(q4.z), fabsf(q4.w))); }
#pragma unroll
            for (int o = 1; o < 64; o <<= 1) am = fmaxf(am, __shfl_xor(am, o));
            if (lane == 0) atomicMax((unsigned*)(ws + WS_CTL) + CW_WAMAX + lq, __builtin_bit_cast(unsigned, am));
        }
        LAS float* scr = (LAS float*)(lds + wave * 16384);
        for (int l = 0; l < 2; ++l) {
            bf16_t* wrkv = (bf16_t*)(ws + WS_WRKV) + (size_t)l * 3 * D * D;
            for (int j = 0; j < 3; ++j) conv_job(IN(5) + ((size_t)l * 3 + j) * D * D, D, D, D, 0, wrkv, D, j * D, 0, nullptr, 0, scr, lane, gw, NGW);
            bf16_t* wldn = (bf16_t*)(ws + WS_WLD) + (size_t)l * LORA_N * 2 * D;
            const float* mix = IN(4) + (size_t)l * 6 * D;
            for (int hpart = 0; hpart < 2; ++hpart) { const int sm = hpart ? 2 : 1, co = hpart ? D : 0;
                conv_job(IN(7) + (size_t)l * D * 96, 96, D, 96, 0, wldn, 2 * D, 0, co, mix + 3 * D, sm, scr, lane, gw, NGW);
                conv_job(IN(10) + (size_t)l * D * 96, 96, D, 96, 0, wldn, 2 * D, 96, co, mix + 4 * D, sm, scr, lane, gw, NGW);
                if (l == 1) conv_job(IN(13), 64, D, 64, 0, wldn, 2 * D, 192, co, mix + 2 * D, sm, scr, lane, gw, NGW);
                conv_job(IN(15) + (size_t)l * D * 256, 256, D, 256, 0, wldn, 2 * D, 256, co, mix + 5 * D, sm, scr, lane, gw, NGW);
            }
            if (l == 0) { for (int idx = gtid; idx < 64 * 2 * D / 8; idx += GT) *(u32x4*)(wldn + (size_t)192 * 2 * D + (size_t)idx * 8) = (u32x4){0u, 0u, 0u, 0u}; }
            bf16_t* wlu = (bf16_t*)(ws + WS_WLU) + (size_t)l * 4 * D * 256;
            conv_lu(IN(8) + (size_t)l * 96 * D, 96, wlu, gtid, GT);
            conv_lu(IN(11) + (size_t)l * 96 * D, 96, wlu + (size_t)D * 256, gtid, GT);
            if (l == 1) conv_lu(IN(14), 64, wlu + (size_t)2 * D * 256, gtid, GT);
            conv_lu(IN(16) + (size_t)l * 256 * D, 256, wlu + (size_t)3 * D * 256, gtid, GT);
            conv_job(IN(22) + (size_t)l * D * D, D, D, D, 0, (bf16_t*)(ws + WS_WWO) + (size_t)l * D * D, D, 0, 0, nullptr, 0, scr, lane, gw, NGW);
        }
        phase_r1((const void*)IN(0), false, IN(1), IN(4), (bf16_t*)(ws + WS_H), (bf16_t*)(ws + WS_XS), gw, NGW, lane);
    }
    PH_END

    layer_body<0>(ph, lo, hi, bar, kp0); layer_body<1>(ph, lo, hi, bar, kp0); layer_body<2>(ph, lo, hi, bar, kp0); layer_body<3>(ph, lo, hi, bar, kp0);
    static_assert(NLAYER == 4, "four layer instantiations");
    PH_BEGIN(15)
    phase_final(X, IN(3), gw, NGW, lane);
    PH_END
#undef PH_BEGIN
#undef IN
#undef PH_END
}
constexpr int N_PHASES = 1 + (9 + 10) + 6 + 5 + 1;

extern "C" void kernel_launch(void* const* d_in, const int* in_sizes, int n_in, void* d_out, int out_size, void* d_ws, size_t ws_size, hipStream_t stream) {
    static int grid = 0;
    if (grid == 0) {
        if (n_in != 30 || in_sizes[0] != S * D || out_size != S * D || ws_size < WS_END) { fprintf(stderr, "kernel_launch: unexpected shapes / workspace (n_in %d, ws %zu)\n", n_in, ws_size); grid = -1; return; }
        int dev = 0, cus = 0, per_cu = 0;
        if (hipGetDevice(&dev) != hipSuccess || hipDeviceGetAttribute(&cus, hipDeviceAttributeMultiprocessorCount, dev) != hipSuccess) { grid = -1; return; }
        if (hipFuncSetAttribute((const void*)mega, hipFuncAttributeMaxDynamicSharedMemorySize, LDS_BYTES) != hipSuccess) { fprintf(stderr, "kernel_launch: hipFuncSetAttribute failed\n"); grid = -1; return; }
        if (hipOccupancyMaxActiveBlocksPerMultiprocessor(&per_cu, (const void*)mega, 512, LDS_BYTES) != hipSuccess || per_cu < 1) { fprintf(stderr, "kernel_launch: occupancy query reports %d\n", per_cu); }
        (void)hipGetLastError();
        grid = cus;
    }
    if (grid < 0) return;
    (void)hipMemsetAsync((char*)d_ws + WS_CTL, 0, CTL_ZERO_BYTES, stream);
    Args a{};
    for (int i = 0; i < 30; ++i) a.in[i] = (const float*)d_in[i];
    a.out = (float*)d_out; a.ws = (unsigned char*)d_ws;
#if MK_SPLIT
    for (int p = 0; p < N_PHASES; ++p) { a.ph_lo = p; a.ph_hi = p + 1; hipLaunchKernelGGL(mega, dim3(grid), dim3(512), LDS_BYTES, stream, a); }
#else
    a.ph_lo = 0; a.ph_hi = N_PHASES;
    hipLaunchKernelGGL(mega, dim3(grid), dim3(512), LDS_BYTES, stream, a);
#endif
}
```

```cpp
#include <hip/hip_runtime.h>
#include <cstdio>
#include <cstdint>

#define LAS __attribute__((address_space(3)))
#define GAS __attribute__((address_space(1)))
typedef unsigned short bf16_t;
typedef short bf16x8 __attribute__((ext_vector_type(8)));
typedef short bf16x4 __attribute__((ext_vector_type(4)));
typedef float f32x4 __attribute__((ext_vector_type(4)));
typedef float f32x16 __attribute__((ext_vector_type(16)));
typedef unsigned u32x4 __attribute__((ext_vector_type(4)));
typedef unsigned u32x2 __attribute__((ext_vector_type(2)));

#ifndef MK_SPLIT
#define MK_SPLIT 0
#endif

constexpr int S = 8192, D = 2048, FF = 8192, NLAYER = 4;
constexpr int RH = 32, RN = 64;
constexpr int FH = 16, FD = 128;
constexpr int LORA_N = 512;
constexpr int KVF_LD = 2 * D + FH;
constexpr float RMS_EPS = 1e-6f;
constexpr float LNX_EPS = 1e-5f * RN;
constexpr float LOG2E = 1.4426950408889634f;
constexpr float QK_SCALE = 0.35709584f;

constexpr size_t MiB = (size_t)1 << 20;
constexpr size_t WS_CTL = 0, CTL_ZERO_BYTES = 1 * MiB;
constexpr size_t WS_WRKV = 1 * MiB;
constexpr size_t WS_WLD = 49 * MiB;
constexpr size_t WS_WLU = 57 * MiB;
constexpr size_t WS_WWO = 65 * MiB;
constexpr size_t WS_WUP01 = 81 * MiB;
constexpr size_t WS_WDN01 = 145 * MiB;
constexpr size_t WS_WQK = 1 * MiB;
constexpr size_t WS_WV = 17 * MiB;
constexpr size_t WS_WFO = 25 * MiB;
constexpr size_t WS_WQ3 = 65 * MiB;
constexpr size_t WS_WUP2 = 81 * MiB;
constexpr size_t WS_WDN2 = 145 * MiB;
constexpr size_t WS_WUP3 = 738 * MiB;
constexpr size_t WS_WDN3 = 930 * MiB;
constexpr size_t WS_CW = 209 * MiB;
constexpr size_t WS_CBH = 241 * MiB;
constexpr size_t WS_CR = 273 * MiB;
constexpr size_t WS_CARB = 305 * MiB;
constexpr size_t WS_CU0 = 337 * MiB;
constexpr size_t WS_CKV = 369 * MiB;
constexpr size_t WS_CY0 = 433 * MiB;
constexpr size_t WS_CGC = 497 * MiB;
constexpr size_t WS_BS = 499 * MiB;
constexpr size_t WS_H = 385 * MiB;
constexpr size_t WS_XS = 418 * MiB;
constexpr size_t WS_R = 514 * MiB;
constexpr size_t WS_K = 578 * MiB;
constexpr size_t WS_V = 642 * MiB;
constexpr size_t WS_VF = 706 * MiB;
constexpr size_t WS_PART = 770 * MiB;
constexpr size_t WS_WLDEC = 834 * MiB;
constexpr size_t WS_A = 898 * MiB;
constexpr size_t WS_G = 962 * MiB;
constexpr size_t WS_END = 994 * MiB;
constexpr size_t WS_Q = WS_WLDEC, WS_KB = WS_WLDEC + 32 * MiB, WS_VT = WS_A, WS_O = WS_G;
constexpr size_t WS_LF = WS_PART, WS_CS = WS_PART + 1 * MiB;
constexpr size_t WS_U = WS_R;
constexpr size_t WS_HF = 674 * MiB;
constexpr size_t WS_YG = WS_R, WS_ACT = WS_XS + 64 * MiB;
constexpr size_t WS_CUT = WS_PART, WS_CS0 = WS_PART + 32 * MiB;
constexpr int CW_SS = 16384;
constexpr int CW_BAR = 4096;
constexpr int CW_WAMAX = 8448;
#ifndef F8_M3_MASK
#define F8_M3_MASK 0xC
#endif

constexpr int RING_BYTES = 131072;
constexpr int MISC_OFF = 163840 - 64;
constexpr int LDS_BYTES = 163840;

typedef __bf16 bf16x2_t __attribute__((ext_vector_type(2)));
typedef float f32x2_t __attribute__((ext_vector_type(2)));
typedef _Float16 f16x2_t __attribute__((ext_vector_type(2)));
__device__ __forceinline__ unsigned cvt_pk_f16(float lo, float hi) { const f32x2_t f = {lo, hi}; const f16x2_t h = __builtin_convertvector(f, f16x2_t); return __builtin_bit_cast(unsigned, h); }
typedef int i32x4 __attribute__((ext_vector_type(4)));
typedef int i32x8 __attribute__((ext_vector_type(8)));
__device__ __forceinline__ unsigned cvt_pk_bf16(float lo, float hi) { const f32x2_t f = {lo, hi}; const bf16x2_t b = __builtin_convertvector(f, bf16x2_t); return __builtin_bit_cast(unsigned, b); }

__device__ __forceinline__ unsigned pk_fp8x4(float a, float b, float c, float d) {
    a = fminf(fmaxf(a, -448.f), 448.f); b = fminf(fmaxf(b, -448.f), 448.f); c = fminf(fmaxf(c, -448.f), 448.f); d = fminf(fmaxf(d, -448.f), 448.f);
    int r = __builtin_amdgcn_cvt_pk_fp8_f32(a, b, 0, false); r = __builtin_amdgcn_cvt_pk_fp8_f32(c, d, r, true); return (unsigned)r;
}
__device__ __forceinline__ float w8_scale(unsigned amax_bits) { unsigned e = (amax_bits >> 23) & 0xffu; e = e < 8u ? 8u : (e > 250u ? 250u : e); return __builtin_bit_cast(float, (260u - e) << 23); }
__device__ __forceinline__ float w8_inv_scale(unsigned amax_bits) { unsigned e = (amax_bits >> 23) & 0xffu; e = e < 8u ? 8u : (e > 250u ? 250u : e); return __builtin_bit_cast(float, (e - 6u) << 23); }
constexpr float U8_SCALE = 8.0f;
__device__ __forceinline__ float wave_sum(float v) {
#pragma unroll
    for (int o = 1; o < 64; o <<= 1) v += __shfl_xor(v, o);
    return v;
}
__device__ __forceinline__ float sigmoidf_(float x) { return 1.0f / (1.0f + __expf(-x)); }
__device__ __forceinline__ float softplusf_(float z) { return fmaxf(z, 0.f) + __logf(1.0f + __expf(-fabsf(z))); }

#define XB_TMO      128
#define XB_XCNT(j)  (256  + 64 * (j))
#define XB_XSUB(j)  (1280 + 64 * (j))
#define XB_XGEN(j)  (2304 + 64 * (j))
#define XB_TOP      3328
#define XB_TOPGEN   3392
#define XCD_BAR_WORDS 3456
#define XB_SPIN_CAP (1u << 18)

__device__ __forceinline__ unsigned xb_ld(unsigned* p)              { return __hip_atomic_load(p, __ATOMIC_RELAXED, __HIP_MEMORY_SCOPE_AGENT); }
__device__ __forceinline__ unsigned xb_add(unsigned* p, unsigned v) { return __hip_atomic_fetch_add(p, v, __ATOMIC_RELAXED, __HIP_MEMORY_SCOPE_AGENT); }
__device__ __forceinline__ unsigned xb_xcc_id() { return (unsigned)__builtin_amdgcn_s_getreg((3 << 11) | 20) & 0xFu; }
#define XB_SPIN(cond, bar) do { unsigned _sp = 0; while (cond) { __builtin_amdgcn_s_sleep(1); \
    if ((++_sp & 255u) == 0u) { if (xb_ld(&(bar)[XB_TMO])) break; if (_sp > XB_SPIN_CAP) { atomicAdd(&(bar)[XB_TMO], 1u); break; } } } } while (0)

struct XcdBarrier { unsigned* bar; unsigned x; volatile LAS unsigned* st; };

__device__ __forceinline__ XcdBarrier xcd_barrier_post(unsigned* bar, volatile LAS unsigned* st) {
    XcdBarrier b; b.bar = bar; b.x = xb_xcc_id(); b.st = st;
    if (threadIdx.x == 0) (void)xb_add(&bar[XB_XCNT(b.x)], 1u);
    return b;
}
__device__ __forceinline__ void xcd_barrier_complete(unsigned* bar, unsigned x, unsigned& nloc, unsigned& nx) {
    const unsigned G = gridDim.x * gridDim.y * gridDim.z;
    unsigned sum, cnt, mine, sp = 0u;
    for (;;) {
        sum = 0u; cnt = 0u; mine = 0u;
#pragma unroll
        for (unsigned j = 0; j < 16; ++j) { const unsigned c = xb_ld(&bar[XB_XCNT(j)]); sum += c; cnt += (c > 0u) ? 1u : 0u; mine = (j == x) ? c : mine; }
        if (sum == G) break;
        __builtin_amdgcn_s_sleep(1);
        if ((++sp & 255u) == 0u) { if (xb_ld(&bar[XB_TMO])) break; if (sp > XB_SPIN_CAP) { atomicAdd(&bar[XB_TMO], 1u); break; } }
    }
    nloc = mine > 0u ? mine : 1u; nx = cnt > 0u ? cnt : 1u;
}
__device__ __forceinline__ void xcd_barrier(const XcdBarrier& b) {
    asm volatile("s_waitcnt vmcnt(0)" ::: "memory");
    __syncthreads();
    if (threadIdx.x == 0) {
        unsigned* bar = b.bar;
        __builtin_amdgcn_s_waitcnt(0);
        unsigned nloc = b.st[0], nx = b.st[1];
        if (nloc == 0u) { xcd_barrier_complete(bar, b.x, nloc, nx); b.st[0] = nloc; b.st[1] = nx; }
        const unsigned old = xb_add(&bar[XB_XSUB(b.x)], 1u);
        const unsigned gen = old / nloc;
        if (old + 1u == (gen + 1u) * nloc) {
            __builtin_amdgcn_fence(__ATOMIC_RELEASE, "agent");
            asm volatile("s_waitcnt vmcnt(0)" ::: "memory");
            const unsigned og = xb_add(&bar[XB_TOP], 1u);
            const unsigned tg = og / nx;
            if (og + 1u == (tg + 1u) * nx) xb_add(&bar[XB_TOPGEN], 1u);
            else XB_SPIN(xb_ld(&bar[XB_TOPGEN]) == tg, bar);
            __builtin_amdgcn_fence(__ATOMIC_ACQUIRE, "agent");
            xb_add(&bar[XB_XGEN(b.x)], 1u);
            asm volatile("s_waitcnt vmcnt(0)" ::: "memory");
        } else {
            XB_SPIN(xb_ld(&bar[XB_XGEN(b.x)]) == gen, bar);
            __builtin_amdgcn_fence(__ATOMIC_ACQUIRE, "agent");
            asm volatile("s_waitcnt vmcnt(0)" ::: "memory");
        }
    }
    __syncthreads();
}

namespace pg8 {
constexpr int BM = 256, BK = 64, HALF = 128, HTB = HALF * BK * 2, STAGE_BYTES = 8 * HTB, NXCD = 8, WGM = 8;
__host__ __device__ __forceinline__ int lds_byte(int r, int c) { const int st = (r >> 4) * 2 + (c >> 5), rr = r & 15, cc = c & 31, ob = rr * 64 + cc * 2; return st * 1024 + (ob ^ (((ob >> 9) & 1) << 5)); }
__host__ __device__ __forceinline__ void stage_rc(int b, int& R, int& C) { const int st = b / 1024, sb = b % 1024, swz = sb ^ (((sb >> 9) & 1) << 5); R = (st >> 1) * 16 + swz / 64; C = (st & 1) * 32 + (swz % 64) / 2; }
__host__ __device__ __forceinline__ int perm32(int rho) { const int n = rho >> 4, i = rho & 15; return 8 * (i >> 2) + 4 * n + (i & 3); }

struct Unit { int pm, pn, ks; };
struct Gemm { const bf16_t* A; const bf16_t* Bt; int lda, ldb, K, agrp; size_t agrp_stride; };

struct StaticOrder {
    int nM, nN, nNe, nwg, G, c;
    __device__ void init(int nM_, int nN_, int KS, int G_, int c_) { nM = nM_; nN = nN_; nNe = nN_ * KS; nwg = nM * nNe; G = G_; c = c_; }
    __device__ bool next(int i, Unit& u) const {
        const long L = (long)i * G + c; if (L >= nwg) return false;
        int wgid = (int)L; { const int q = nwg / NXCD, r = nwg % NXCD, xcd = wgid % NXCD, off = wgid / NXCD; wgid = (xcd < r ? xcd * (q + 1) : r * (q + 1) + (xcd - r) * q) + off; }
        const int nig = WGM * nNe, gid = wgid / nig, fm = gid * WGM, gsz = (nM - fm) < WGM ? (nM - fm) : WGM;
        u.pm = fm + ((wgid % nig) % gsz); const int pne = (wgid % nig) / gsz; u.pn = pne % nN; u.ks = pne / nN; return true;
    }
};

enum { EPI_F32 = 0, EPI_RES = 1, EPI_BF16 = 2, EPI_RELU2 = 3, EPI_LW = 4, EPI_LA = 5, EPI_LV = 6 };
template <int MODE> struct Epi {
    static constexpr bool PERM = (MODE == EPI_BF16 || MODE == EPI_RELU2 || MODE == EPI_LA || MODE == EPI_LV);
    void* o0; void* o1; void* o2;
    const void* src;
    const float* vec;
    int ldc, split_cols; size_t ks_stride; float scale;
    bf16_t* xb = nullptr; unsigned long long* ss = nullptr;
    const unsigned long long* rss = nullptr;
    int res_mode = 0;
    unsigned* kmp = nullptr;
    int vperm = 0;
    int q8 = 0;
    const unsigned* wamax = nullptr;
    __device__ __forceinline__ void operator()(const f32x4 (&acc)[2][2][4][2], const Unit& u, int wr, int wc, int fr, int fq) const {
        int colt = u.pn * BM; void* basev = o0;
        int tsplit = 0;
        if (split_cols) { const int t = colt / split_cols; colt -= t * split_cols; basev = (t == 0) ? o0 : ((t == 1) ? o1 : o2); tsplit = t; }
        const int row0 = u.pm * BM + wr * 64 + fr;
        if constexpr (PERM) {
            bf16_t* base = (bf16_t*)basev + (size_t)u.ks * ks_stride;
            const int col0 = colt + wc * 32 + 8 * fq, vcol0 = u.pn * BM + wc * 32 + 8 * fq;
            float pmax[2] = {0.f, 0.f};
            f32x4 bv[2][2];
            if constexpr (MODE == EPI_LA || MODE == EPI_LV) {
#pragma unroll
                for (int bj = 0; bj < 2; ++bj)
#pragma unroll
                    for (int hf = 0; hf < 2; ++hf) bv[bj][hf] = *(const f32x4*)(vec + vcol0 + bj * HALF + 4 * hf);
            }
#pragma unroll
            for (int ai = 0; ai < 2; ++ai)
#pragma unroll
                for (int m = 0; m < 4; ++m) { const size_t roff = (size_t)(row0 + ai * HALF + m * 16) * ldc + col0; bf16_t* rowp = base + roff;
                    float rs = 1.f; if constexpr (MODE == EPI_RELU2 || MODE == EPI_BF16) { if (rss) rs = rsqrtf((float)rss[row0 + ai * HALF + m * 16] * (1.0f / (65536.0f * D)) + RMS_EPS); }
#pragma unroll
                    for (int bj = 0; bj < 2; ++bj) { f32x4 v0 = acc[ai][bj][m][0], v1 = acc[ai][bj][m][1];
                        if constexpr (MODE == EPI_RELU2) {
#pragma unroll
                            for (int j = 0; j < 4; ++j) { const float a = fmaxf(v0[j], 0.f) * rs, b = fmaxf(v1[j], 0.f) * rs; v0[j] = a * a; v1[j] = b * b; }
                        } else if constexpr (MODE == EPI_LA) {
#pragma unroll
                            for (int j = 0; j < 4; ++j) { v0[j] = sigmoidf_(v0[j] + bv[bj][0][j]); v1[j] = sigmoidf_(v1[j] + bv[bj][1][j]); }
                        } else if constexpr (MODE == EPI_LV) {
                            const u32x4 cw = *(const u32x4*)(rowp + bj * HALF), fw = *(const u32x4*)((const bf16_t*)src + roff + bj * HALF);
#pragma unroll
                            for (int j = 0; j < 4; ++j) { const unsigned cu = cw[j >> 1], fu = fw[j >> 1], cu1 = cw[2 + (j >> 1)], fu1 = fw[2 + (j >> 1)];
                                const float c0 = __builtin_bit_cast(float, (j & 1) ? (cu & 0xffff0000u) : (cu << 16)), f0 = __builtin_bit_cast(float, (j & 1) ? (fu & 0xffff0000u) : (fu << 16));
                                const float c1 = __builtin_bit_cast(float, (j & 1) ? (cu1 & 0xffff0000u) : (cu1 << 16)), f1 = __builtin_bit_cast(float, (j & 1) ? (fu1 & 0xffff0000u) : (fu1 << 16));
                                v0[j] = c0 + (f0 - c0) * sigmoidf_(v0[j] + bv[bj][0][j]); v1[j] = c1 + (f1 - c1) * sigmoidf_(v1[j] + bv[bj][1][j]); }
                        } else { v0 = v0 * (scale * rs); v1 = v1 * (scale * rs);
                            if constexpr (MODE == EPI_BF16) { if (kmp && tsplit == 1) { float ps = ((v0[0] * v0[0] + v0[1] * v0[1]) + (v0[2] * v0[2] + v0[3] * v0[3])) + ((v1[0] * v1[0] + v1[1] * v1[1]) + (v1[2] * v1[2] + v1[3] * v1[3]));
                                ps += __shfl_xor(ps, 16); ps += __shfl_xor(ps, 32); pmax[bj] = fmaxf(pmax[bj], ps); } } }
                        if constexpr (MODE == EPI_RELU2) { if (q8) {
                            const u32x2 w8 = (u32x2){pk_fp8x4(v0[0] * U8_SCALE, v0[1] * U8_SCALE, v0[2] * U8_SCALE, v0[3] * U8_SCALE), pk_fp8x4(v1[0] * U8_SCALE, v1[1] * U8_SCALE, v1[2] * U8_SCALE, v1[3] * U8_SCALE)};
                            *(GAS u32x2*)((unsigned char*)basev + roff + bj * HALF) = w8; continue; } }
                        u32x4 w; w.x = cvt_pk_bf16(v0[0], v0[1]); w.y = cvt_pk_bf16(v0[2], v0[3]); w.z = cvt_pk_bf16(v1[0], v1[1]); w.w = cvt_pk_bf16(v1[2], v1[3]);
                        if constexpr (MODE == EPI_BF16) { if (vperm) { bf16_t* p_ = rowp + bj * HALF - 4 * (fq & 1); *(GAS u32x2*)p_ = (u32x2){w.x, w.y}; *(GAS u32x2*)(p_ + 8) = (u32x2){w.z, w.w}; continue; } }
                        *(u32x4*)(rowp + bj * HALF) = w; } }
            if constexpr (MODE == EPI_BF16) { if (kmp && tsplit == 1) {
#pragma unroll
                for (int bj = 0; bj < 2; ++bj) { float pm = pmax[bj]; pm = fmaxf(pm, __shfl_xor(pm, 1)); pm = fmaxf(pm, __shfl_xor(pm, 2)); pm = fmaxf(pm, __shfl_xor(pm, 4)); pm = fmaxf(pm, __shfl_xor(pm, 8));
                    if (fr == 0 && fq == 0) atomicMax(kmp + (colt / 128 + bj) * 4 + wc, __builtin_bit_cast(unsigned, pm)); } } }
        } else {
            float* base = (float*)basev + (size_t)u.ks * ks_stride;
            const int col0 = colt + wc * 32 + 4 * fq, vcol0 = u.pn * BM + wc * 32 + 4 * fq;
            f32x4 bv[2][2];
            if constexpr (MODE == EPI_LW) {
#pragma unroll
                for (int bj = 0; bj < 2; ++bj)
#pragma unroll
                    for (int n = 0; n < 2; ++n) bv[bj][n] = *(const f32x4*)(vec + vcol0 + bj * HALF + n * 16);
            }
            if constexpr (MODE == EPI_RES) {
                const float osc = wamax ? w8_inv_scale(__hip_atomic_load(wamax, __ATOMIC_RELAXED, __HIP_MEMORY_SCOPE_AGENT)) * (1.0f / U8_SCALE) : 1.0f;
#pragma unroll
                for (int ai = 0; ai < 2; ++ai) {
                    f32x4 sv[4][2][2];
                    if (res_mode >= 2) {
#pragma unroll
                        for (int m = 0; m < 4; ++m)
#pragma unroll
                            for (int bj = 0; bj < 2; ++bj)
#pragma unroll
                                for (int n = 0; n < 2; ++n) { const u32x2 w_ = *(const GAS u32x2*)((const bf16_t*)src + (size_t)(row0 + ai * HALF + m * 16) * ldc + col0 + bj * HALF + n * 16);
                                    sv[m][bj][n] = (f32x4){__builtin_bit_cast(float, w_.x << 16), __builtin_bit_cast(float, w_.x & 0xffff0000u), __builtin_bit_cast(float, w_.y << 16), __builtin_bit_cast(float, w_.y & 0xffff0000u)}; }
                    } else {
#pragma unroll
                    for (int m = 0; m < 4; ++m)
#pragma unroll
                        for (int bj = 0; bj < 2; ++bj)
#pragma unroll
                            for (int n = 0; n < 2; ++n) sv[m][bj][n] = *(const GAS f32x4*)((const float*)src + (size_t)(row0 + ai * HALF + m * 16) * ldc + col0 + bj * HALF + n * 16);
                    }
#pragma unroll
                    for (int m = 0; m < 4; ++m) { const size_t roff = (size_t)(row0 + ai * HALF + m * 16) * ldc + col0; float psum = 0.f;
#pragma unroll
                        for (int bj = 0; bj < 2; ++bj)
#pragma unroll
                            for (int n = 0; n < 2; ++n) { const size_t off = roff + bj * HALF + n * 16; const f32x4 v = acc[ai][bj][m][n] * osc + sv[m][bj][n];
                                if (xb) *(GAS u32x2*)(xb + off) = (u32x2){cvt_pk_bf16(v[0], v[1]), cvt_pk_bf16(v[2], v[3])};
                                if (ss) psum += (v[0] * v[0] + v[1] * v[1]) + (v[2] * v[2] + v[3] * v[3]);
                                if (res_mode == 0 || res_mode == 2) *(GAS f32x4*)(base + off) = v; }
                        if (ss) { psum += __shfl_xor(psum, 16); psum += __shfl_xor(psum, 32); if (fq == 0) atomicAdd(ss + row0 + ai * HALF + m * 16, (unsigned long long)(psum * 65536.0f)); } }
                }
            } else {
#pragma unroll
            for (int ai = 0; ai < 2; ++ai)
#pragma unroll
                for (int m = 0; m < 4; ++m) { const size_t roff = (size_t)(row0 + ai * HALF + m * 16) * ldc + col0;
#pragma unroll
                    for (int bj = 0; bj < 2; ++bj)
#pragma unroll
                        for (int n = 0; n < 2; ++n) { const size_t off = roff + bj * HALF + n * 16; f32x4 v = acc[ai][bj][m][n];
                            if constexpr (MODE == EPI_LW) {
#pragma unroll
                                for (int j = 0; j < 4; ++j) { const float uu = v[j] + bv[bj][n][j]; const float wl = -softplusf_(-uu) - 0.5f; v[j] = -__expf(wl); }
                                *(GAS u32x2*)((_Float16*)basev + off) = (u32x2){cvt_pk_f16(v[0], v[1]), cvt_pk_f16(v[2], v[3])}; continue; }
                            *(f32x4*)(base + off) = v; } }
            }
        }
    }
};

template <class EpiT, bool F8 = false>
__device__ __forceinline__ void gemm_phase(LAS unsigned char* lds, const Gemm g, const StaticOrder& S_, const EpiT& E, const int tid) {
    const int wid = __builtin_amdgcn_readfirstlane(tid >> 6), lane = tid & 63, wr = wid >> 2, wc = wid & 3, fr = lane & 15, fq = lane >> 4;
    int K = g.K, lda_ = g.lda, ldb_ = g.ldb; asm volatile("" : "+s"(K), "+s"(lda_), "+s"(ldb_));
    const int nt = K / BK;
    unsigned voffA[2], voffB[2];
#pragma unroll
    for (int i = 0; i < 2; ++i) { int R, C; stage_rc(tid * 16 + i * 8192, R, C); const int Rb = EpiT::PERM ? ((R & ~31) + perm32(R & 31)) : R;
        voffA[i] = (unsigned)(R * lda_ + C) * 2u; voffB[i] = (unsigned)(Rb * ldb_ + C) * 2u; }
    const size_t kstep = (size_t)(BK * 2);
    const size_t hstepA = (size_t)HALF * lda_ * 2, hstepB = (size_t)HALF * ldb_ * 2;
    const unsigned ldsw = (unsigned)wid * 1024u;
    const int aoff = lds_byte(wr * 64 + fr, fq * 8), boff = lds_byte(wc * 32 + fr, fq * 8);
#define PG8_SA(b, h) (((b) * 2 + (h)) * HTB)
#define PG8_SB(b, h) ((4 + (b) * 2 + (h)) * HTB)
#define PG8_STAGE(bufoff, gbase, voff) do { _Pragma("unroll") for (int _i = 0; _i < 2; ++_i) \
        __builtin_amdgcn_global_load_lds((const unsigned*)((const char*)(gbase) + (voff)[_i]), (LAS unsigned*)(lds + (bufoff) + ldsw + _i * 8192), 16, 0, 0); } while (0)
#define PG8_LDA(dst, b, h) do { _Pragma("unroll") for (int m = 0; m < 4; ++m) _Pragma("unroll") for (int k = 0; k < 2; ++k) dst[m][k] = *(const LAS bf16x8*)(lds + PG8_SA(b, h) + aoff + m * 2048 + k * 1024); } while (0)
#define PG8_LDB(dst, b, h) do { _Pragma("unroll") for (int n = 0; n < 2; ++n) _Pragma("unroll") for (int k = 0; k < 2; ++k) dst[n][k] = *(const LAS bf16x8*)(lds + PG8_SB(b, h) + boff + n * 2048 + k * 1024); } while (0)
#define PG8_MMA(ai, bj, At, Bt) do { __builtin_amdgcn_s_setprio(1); _Pragma("unroll") for (int m = 0; m < 4; ++m) _Pragma("unroll") for (int n = 0; n < 2; ++n) { \
        if constexpr (F8) { const i32x8 a8_ = __builtin_shufflevector(__builtin_bit_cast(i32x4, At[m][0]), __builtin_bit_cast(i32x4, At[m][1]), 0, 1, 2, 3, 4, 5, 6, 7); \
            const i32x8 b8_ = __builtin_shufflevector(__builtin_bit_cast(i32x4, Bt[n][0]), __builtin_bit_cast(i32x4, Bt[n][1]), 0, 1, 2, 3, 4, 5, 6, 7); \
            asm volatile("v_mfma_f32_16x16x128_f8f6f4 %0, %1, %2, %0" : "+v"(acc[ai][bj][m][n]) : "v"(b8_), "v"(a8_)); \
        } else { _Pragma("unroll") for (int k = 0; k < 2; ++k) acc[ai][bj][m][n] = __builtin_amdgcn_mfma_f32_16x16x32_bf16(Bt[n][k], At[m][k], acc[ai][bj][m][n], 0, 0, 0); } } \
        __builtin_amdgcn_s_setprio(0); } while (0)
#define PG8_WAIT_V(n) asm volatile("s_waitcnt vmcnt(" #n ")" ::: "memory")
#define PG8_WAIT_L(n) asm volatile("s_waitcnt lgkmcnt(" #n ")" ::: "memory")
#define PG8_BAR __builtin_amdgcn_s_barrier()
#define PG8_SCHED __builtin_amdgcn_sched_barrier(0)
#define PG8_UPTR(u, pa, pb) do { pa = (const char*)g.A + ((size_t)((u).pn / g.agrp) * g.agrp_stride + (size_t)(u).pm * BM * lda_ + (size_t)(u).ks * K) * 2; \
                                 pb = (const char*)g.Bt + ((size_t)(u).pn * BM * ldb_ + (size_t)(u).ks * K) * 2; } while (0)
    Unit cur, nxt; int ui = 0;
    if (!S_.next(0, cur)) return;
    f32x4 acc[2][2][4][2];
#pragma unroll
    for (int a = 0; a < 2; ++a)
#pragma unroll
        for (int b = 0; b < 2; ++b)
#pragma unroll
            for (int m = 0; m < 4; ++m)
#pragma unroll
                for (int n = 0; n < 2; ++n) acc[a][b][m][n] = (f32x4){0.f, 0.f, 0.f, 0.f};
    bf16x8 At[4][2], B0[2][2], B1[2][2];
    const char* cA; const char* cB; PG8_UPTR(cur, cA, cB);
    PG8_STAGE(PG8_SB(0, 0), cB, voffB); PG8_STAGE(PG8_SB(0, 1), cB + hstepB, voffB); PG8_STAGE(PG8_SA(0, 0), cA, voffA); PG8_STAGE(PG8_SA(0, 1), cA + hstepA, voffA);
    if (wr == 1) PG8_BAR;
    PG8_WAIT_V(2); PG8_BAR;
    PG8_STAGE(PG8_SB(1, 0), cB + kstep, voffB); PG8_STAGE(PG8_SA(1, 0), cA + kstep, voffA); PG8_STAGE(PG8_SB(1, 1), cB + hstepB + kstep, voffB);
    PG8_WAIT_V(6); PG8_BAR;
    for (;;) {
        const bool has_next = S_.next(ui + 1, nxt);
        const char* nA = cA; const char* nB = cB; if (has_next) PG8_UPTR(nxt, nA, nB);
        for (int t = 0; t < nt; t += 2) {
            const bool last = (t == nt - 2);
            const char* a1 = cA + (size_t)(t + 1) * kstep;
            const char* a2 = last ? nA : cA + (size_t)(t + 2) * kstep; const char* b2 = last ? nB : cB + (size_t)(t + 2) * kstep;
            const char* a3 = a2 + kstep; const char* b3 = b2 + kstep;
            PG8_LDB(B0, 0, 0); PG8_LDB(B1, 0, 1); PG8_SCHED; PG8_LDA(At, 0, 0); PG8_STAGE(PG8_SA(1, 1), a1 + hstepA, voffA);
            PG8_WAIT_V(8); PG8_WAIT_L(0); PG8_BAR; PG8_MMA(0, 0, At, B0); PG8_MMA(0, 1, At, B1); PG8_BAR; PG8_SCHED;
            PG8_LDA(At, 0, 1); PG8_STAGE(PG8_SB(0, 0), b2, voffB); PG8_STAGE(PG8_SB(0, 1), b2 + hstepB, voffB); PG8_STAGE(PG8_SA(0, 0), a2, voffA);
            PG8_WAIT_V(8); PG8_WAIT_L(0); PG8_BAR; PG8_MMA(1, 0, At, B0); PG8_MMA(1, 1, At, B1); PG8_BAR; PG8_SCHED;
            PG8_LDB(B0, 1, 0); PG8_LDB(B1, 1, 1); PG8_SCHED; PG8_LDA(At, 1, 0); PG8_STAGE(PG8_SA(0, 1), a2 + hstepA, voffA);
            PG8_WAIT_V(8); PG8_WAIT_L(0); PG8_BAR; PG8_MMA(0, 0, At, B0); PG8_MMA(0, 1, At, B1); PG8_BAR; PG8_SCHED;
            PG8_LDA(At, 1, 1); PG8_STAGE(PG8_SB(1, 0), b3, voffB); PG8_STAGE(PG8_SB(1, 1), b3 + hstepB, voffB); PG8_STAGE(PG8_SA(1, 0), a3, voffA);
            PG8_WAIT_V(8); PG8_WAIT_L(0); PG8_BAR; PG8_MMA(1, 0, At, B0); PG8_MMA(1, 1, At, B1); PG8_BAR; PG8_SCHED;
        }
        if constexpr (F8) asm volatile("s_nop 15\n\ts_nop 15" ::: "memory");
        if (wr == 0) PG8_BAR;
        E(acc, cur, wr, wc, fr, fq);
        if (!has_next) break;
#pragma unroll
        for (int a = 0; a < 2; ++a)
#pragma unroll
            for (int b = 0; b < 2; ++b)
#pragma unroll
                for (int m = 0; m < 4; ++m)
#pragma unroll
                    for (int n = 0; n < 2; ++n) acc[a][b][m][n] = (f32x4){0.f, 0.f, 0.f, 0.f};
        cur = nxt; cA = nA; cB = nB; ++ui;
        if (wr == 1) PG8_BAR;
    }
    PG8_WAIT_V(0);
    PG8_BAR;
#undef PG8_SA
#undef PG8_SB
#undef PG8_STAGE
#undef PG8_LDA
#undef PG8_LDB
#undef PG8_MMA
#undef PG8_WAIT_V
#undef PG8_WAIT_L
#undef PG8_BAR
#undef PG8_SCHED
#undef PG8_UPTR
}
}

constexpr int CONV_SCR = 4344;
__device__ __forceinline__ void conv_issue(f32x4 (&v)[8], const float* W, int ldw, int lane, bool f8 = false) {
    const int lr8 = lane >> 3, lc = (lane & 7) * 4;
#pragma unroll
    for (int i = 0; i < 8; ++i) v[i] = __builtin_nontemporal_load((const GAS f32x4*)(W + (size_t)(f8 ? 32 * (i >> 2) + 4 * lr8 + (i & 3) : 16 * (i >> 1) + 2 * lr8 + (i & 1)) * ldw + lc));
}
__device__ __forceinline__ void conv_finish(const f32x4 (&v)[8], bf16_t* WT, int ldt, const float* sc, int smode, LAS unsigned* scr, int lane) {
    const int lr8 = lane >> 3, l7 = lane & 7;
    if (smode == 3) {
        const float s8 = w8_scale(__hip_atomic_load((const unsigned*)sc, __ATOMIC_RELAXED, __HIP_MEMORY_SCOPE_AGENT));
#pragma unroll
        for (int m = 0; m < 2; ++m)
#pragma unroll
            for (int e = 0; e < 4; ++e) scr[(4 * l7 + e) * 18 + 8 * m + lr8] = pk_fp8x4(v[4 * m][e] * s8, v[4 * m + 1][e] * s8, v[4 * m + 2][e] * s8, v[4 * m + 3][e] * s8);
        asm volatile("s_waitcnt lgkmcnt(0)" ::: "memory");
#pragma unroll
        for (int j = 0; j < 4; ++j) { const int n = lr8 + 8 * j; const u32x2 o = *(const LAS u32x2*)(scr + n * 18 + 2 * l7);
            *(GAS u32x2*)((unsigned char*)WT + (size_t)n * ldt + 8 * l7) = o; }
        asm volatile("s_waitcnt lgkmcnt(0)" ::: "memory");
        return;
    }
#pragma unroll
    for (int m = 0; m < 4; ++m) { f32x4 lo = v[2 * m], hi = v[2 * m + 1];
        if (smode) { const f32x2_t sv_ = *(const GAS f32x2_t*)(sc + 16 * m + 2 * lr8); float s0 = sv_[0], s1 = sv_[1]; if (smode == 2) { s0 = 1.0f - s0; s1 = 1.0f - s1; } lo = lo * s0; hi = hi * s1; }
#pragma unroll
        for (int e = 0; e < 4; ++e) scr[(4 * l7 + e) * 34 + 8 * m + lr8] = cvt_pk_bf16(lo[e], hi[e]); }
    asm volatile("s_waitcnt lgkmcnt(0)" ::: "memory");
#pragma unroll
    for (int j = 0; j < 4; ++j) { const int n = lr8 + 8 * j; const LAS unsigned* p = scr + n * 34 + 4 * l7;
        const u32x2 o0 = *(const LAS u32x2*)p, o1 = *(const LAS u32x2*)(p + 2);
        *(GAS u32x4*)(WT + (size_t)n * ldt + 8 * l7) = (u32x4){o0.x, o0.y, o1.x, o1.y}; }
    asm volatile("s_waitcnt lgkmcnt(0)" ::: "memory");
}
__device__ __forceinline__ void conv_tile(const float* W, int ldw, bf16_t* WT, int ldt, int k0, int n0, int dst_row0, int dst_col0,
                                          const float* sc, int smode, LAS float* scr, int lane) {
    f32x4 v[8];
    conv_issue(v, W + (size_t)k0 * ldw + n0, ldw, lane);
    conv_finish(v, WT + (size_t)dst_row0 * ldt + dst_col0 + k0, ldt, sc + k0, smode, (LAS unsigned*)scr, lane);
}
__device__ __forceinline__ void conv_job(const float* W, int ldw, int K, int N, int n_begin, bf16_t* WT, int ldt, int row_off, int col_off,
                                         const float* sc, int smode, LAS float* scr, int lane, int gw, int NGW) {
    const int nblk = N / 32, nitems = (K / 64) * nblk;
    for (int it = gw; it < nitems; it += NGW) { const int kb = it / nblk, nb = it % nblk;
        conv_tile(W, ldw, WT, ldt, 64 * kb, n_begin + 32 * nb, row_off + 32 * nb, col_off, sc, smode, scr, lane); }
}
__device__ __forceinline__ void conv_lu(const float* W, int Kr, bf16_t* WT, int gtid, int GT) {
    for (int idx = gtid; idx < 32 * 2048; idx += GT) { const int n = idx & 2047, kc = idx >> 11; float v[8];
#pragma unroll
        for (int i = 0; i < 8; ++i) { const int k = kc * 8 + i; v[i] = (k < Kr) ? W[(size_t)k * 2048 + n] : 0.f; }
        u32x4 o; o.x = cvt_pk_bf16(v[0], v[1]); o.y = cvt_pk_bf16(v[2], v[3]); o.z = cvt_pk_bf16(v[4], v[5]); o.w = cvt_pk_bf16(v[6], v[7]);
        *(u32x4*)(WT + (size_t)n * 256 + kc * 8) = o; }
}

struct Args { const float* in[30]; float* out; unsigned char* ws; int ph_lo, ph_hi; };

__device__ __forceinline__ float row_rstd(const f32x4 (&v)[8]) {
    float s = 0.f;
#pragma unroll
    for (int j = 0; j < 8; ++j) s += (v[j].x * v[j].x + v[j].y * v[j].y) + (v[j].z * v[j].z + v[j].w * v[j].w);
    return rsqrtf(wave_sum(s) * (1.0f / D) + RMS_EPS);
}
__device__ __forceinline__ void store_bf16x4(bf16_t* p, f32x4 v) { u32x2 o; o.x = cvt_pk_bf16(v.x, v.y); o.y = cvt_pk_bf16(v.z, v.w); *(u32x2*)p = o; }

__device__ __forceinline__ void load_row(f32x4 (&v)[8], const void* x, bool isbf, int t, int lane) {
    if (isbf) { const u32x2* xr = (const u32x2*)((const bf16_t*)x + (size_t)t * D) + lane;
#pragma unroll
        for (int j = 0; j < 8; ++j) { const u32x2 w_ = xr[64 * j]; v[j] = (f32x4){__builtin_bit_cast(float, w_.x << 16), __builtin_bit_cast(float, w_.x & 0xffff0000u), __builtin_bit_cast(float, w_.y << 16), __builtin_bit_cast(float, w_.y & 0xffff0000u)}; }
    } else { const f32x4* xr = (const f32x4*)((const float*)x + (size_t)t * D) + lane;
#pragma unroll
        for (int j = 0; j < 8; ++j) v[j] = xr[64 * j]; }
}
__device__ __forceinline__ void phase_r1(const void* x, bool isbf, const float* gain, const float* mix, bf16_t* hbuf, bf16_t* xs, int gw, int NGW, int lane) {
    f32x4 gvr[8], mvr[3][8];
#pragma unroll
    for (int j = 0; j < 8; ++j) { const int c = 4 * (lane + 64 * j); gvr[j] = *(const f32x4*)(gain + c);
#pragma unroll
        for (int q = 0; q < 3; ++q) mvr[q][j] = *(const f32x4*)(mix + q * D + c); }
    for (int t = gw; t < S; t += NGW) {
        f32x4 xv[8], pv[8];
        load_row(xv, x, isbf, t, lane);
        if (t > 0) { load_row(pv, x, isbf, t - 1, lane);
        } else {
#pragma unroll
            for (int j = 0; j < 8; ++j) pv[j] = (f32x4){0.f, 0.f, 0.f, 0.f};
        }
        const float rs = row_rstd(xv), rp = row_rstd(pv);
#pragma unroll
        for (int j = 0; j < 8; ++j) { const int c = 4 * (lane + 64 * j); const f32x4 gv = gvr[j];
            const f32x4 h = xv[j] * rs * gv, hp = pv[j] * rp * gv, d = hp - h;
            store_bf16x4(hbuf + (size_t)(t + 1) * D + c, h);
            if (t == 0) store_bf16x4(hbuf + c, (f32x4){0.f, 0.f, 0.f, 0.f});
#pragma unroll
            for (int q = 0; q < 3; ++q) { const f32x4 mv = mvr[q][j]; store_bf16x4(xs + (size_t)q * S * D + (size_t)t * D + c, h + d * mv); }
        }
    }
}
__device__ __forceinline__ void phase_final(float* x, const float* g0, int gw, int NGW, int lane) {
    f32x4 gvr[8];
#pragma unroll
    for (int j = 0; j < 8; ++j) gvr[j] = *(const f32x4*)(g0 + 4 * (lane + 64 * j));
    for (int t = gw; t < S; t += NGW) {
        f32x4 xv[8]; f32x4* xr = (f32x4*)(x + (size_t)t * D) + lane;
#pragma unroll
        for (int j = 0; j < 8; ++j) xv[j] = xr[64 * j];
        const float rs = row_rstd(xv);
#pragma unroll
        for (int j = 0; j < 8; ++j) xr[64 * j] = xv[j] * rs * gvr[j];
    }
}
__device__ __forceinline__ void phase_f0(const bf16_t* x, const float* gq, bf16_t* hq, const float* gk, bf16_t* hk, const float* wkvf, const float* bf, float* lf,
                                         LAS float* wl, int gw, int NGW, int lane, int tid) {
    for (int i = tid; i < D * FH; i += 512) { const int d = i >> 4, j = i & 15; wl[j * D + d] = wkvf[(size_t)d * KVF_LD + 2 * D + j]; }
    __syncthreads();
    f32x4 gqr[8], gkr[8]; const float bfl = bf[lane & (FH - 1)];
#pragma unroll
    for (int j = 0; j < 8; ++j) { gqr[j] = *(const f32x4*)(gq + 4 * (lane + 64 * j)); gkr[j] = *(const f32x4*)(gk + 4 * (lane + 64 * j)); }
    for (int t = gw; t < S; t += NGW) {
        f32x4 xv[8]; load_row(xv, x, true, t, lane);
        const float rs = row_rstd(xv);
        LAS float* wl_ = wl; asm volatile("" : "+v"(wl_));
        float fa[FH];
#pragma unroll
        for (int j = 0; j < FH; ++j) fa[j] = 0.f;
#pragma unroll
        for (int j = 0; j < 8; ++j) { const int c = 4 * (lane + 64 * j); const f32x4 xn = xv[j] * rs; const f32x4 hkv = xn * gkr[j];
            store_bf16x4(hq + (size_t)t * D + c, xn * gqr[j]);
            store_bf16x4(hk + (size_t)t * D + c, hkv);
#pragma unroll
            for (int q = 0; q < FH; ++q) { const f32x4 w = *(const LAS f32x4*)(wl_ + q * D + c); fa[q] += (hkv.x * w.x + hkv.y * w.y) + (hkv.z * w.z + hkv.w * w.w); }
        }
#pragma unroll
        for (int q = 0; q < FH; ++q) fa[q] = wave_sum(fa[q]);
        if (lane < FH) { float z = 0.f;
#pragma unroll
            for (int q = 0; q < FH; ++q) z = (lane == q) ? fa[q] : z;
            z += bfl; lf[(size_t)t * FH + lane] = -softplusf_(-z); }
    }
}
__device__ __forceinline__ void phase_cumsum(const float* lf, float* cs2, int hd, LAS double* sc, int tid) {
    const int lane = tid & 63, wid = tid >> 6;
    double loc[16]; double s = 0.0;
#pragma unroll
    for (int i = 0; i < 16; ++i) { s += (double)lf[(size_t)(tid * 16 + i) * FH + hd]; loc[i] = s; }
    double incl = s;
#pragma unroll
    for (int o = 1; o < 64; o <<= 1) { const double up = __shfl_up(incl, o); if (lane >= o) incl += up; }
    if (lane == 63) sc[wid] = incl;
    __syncthreads();
    double base = incl - s;
    for (int w = 0; w < wid; ++w) base += sc[w];
#pragma unroll
    for (int i = 0; i < 16; ++i) cs2[(size_t)hd * S + tid * 16 + i] = (float)(-(base + loc[i]) * (double)LOG2E);
    __syncthreads();
}
__device__ __forceinline__ void phase_r3(const bf16_t* part, bf16_t* act, int gtid, int GT) {
    for (int idx = gtid; idx < S * 128; idx += GT) { const int t = idx >> 7, c = (idx & 127) * 4;
        f32x4 v = (f32x4){0.f, 0.f, 0.f, 0.f};
#pragma unroll
        for (int p = 0; p < 4; ++p) { const u32x2 w_ = *(const u32x2*)(part + (size_t)p * S * LORA_N + (size_t)t * LORA_N + c);
            v = v + (f32x4){__builtin_bit_cast(float, w_.x << 16), __builtin_bit_cast(float, w_.x & 0xffff0000u), __builtin_bit_cast(float, w_.y << 16), __builtin_bit_cast(float, w_.y & 0xffff0000u)}; }
        if (c < 96) { f32x4 o; o.x = tanhf(v.x); o.y = tanhf(v.y); o.z = tanhf(v.z); o.w = tanhf(v.w); store_bf16x4(act + (size_t)t * 256 + c, o); }
        else if (c < 192) store_bf16x4(act + (size_t)S * 256 + (size_t)t * 256 + (c - 96), v);
        else if (c < 256) store_bf16x4(act + (size_t)2 * S * 256 + (size_t)t * 256 + (c - 192), v);
        else { f32x4 o; o.x = sigmoidf_(v.x); o.y = sigmoidf_(v.y); o.z = sigmoidf_(v.z); o.w = sigmoidf_(v.w); store_bf16x4(act + (size_t)3 * S * 256 + (size_t)t * 256 + (c - 256), o); }
        const int z = idx & 127;
        if (z < 40) { store_bf16x4(act + (size_t)t * 256 + 96 + 4 * z, (f32x4){0.f, 0.f, 0.f, 0.f}); store_bf16x4(act + (size_t)S * 256 + (size_t)t * 256 + 96 + 4 * z, (f32x4){0.f, 0.f, 0.f, 0.f}); }
        if (z < 48) store_bf16x4(act + (size_t)2 * S * 256 + (size_t)t * 256 + 64 + 4 * z, (f32x4){0.f, 0.f, 0.f, 0.f});
    }
}

__device__ __forceinline__ float dpp_f(float v, const int ctrl_sel) {
    int r;
    if (ctrl_sel == 0) r = __builtin_amdgcn_update_dpp(0, __builtin_bit_cast(int, v), 0xB1, 0xF, 0xF, true);
    else if (ctrl_sel == 1) r = __builtin_amdgcn_update_dpp(0, __builtin_bit_cast(int, v), 0x4E, 0xF, 0xF, true);
    else if (ctrl_sel == 2) r = __builtin_amdgcn_update_dpp(0, __builtin_bit_cast(int, v), 0x141, 0xF, 0xF, true);
    else r = __builtin_amdgcn_update_dpp(0, __builtin_bit_cast(int, v), 0x140, 0xF, 0xF, true);
    return __builtin_bit_cast(float, r);
}
__device__ __forceinline__ float red16(float v) { v += dpp_f(v, 0); v += dpp_f(v, 1); v += dpp_f(v, 2); v += dpp_f(v, 3); return v; }

constexpr int NCHUNK = S / 64, NUNIT = RH * NCHUNK;
typedef const __attribute__((address_space(4))) unsigned long long* KP;
#ifndef RIDE
#define RIDE 1
#endif
#ifndef C2_CONV_FROM
#define C2_CONV_FROM 16384
#endif
struct ConvD { const float* W; bf16_t* WT; const float* sc; int ldw, ldt, smode; };
__device__ __forceinline__ int c1_conv_ntiles(int l) { return l == 0 ? 32768 : 32768 + 6 * 2048; }
__device__ __forceinline__ ConvD c1_conv_desc(KP kp, int l, int T) {
    unsigned char* ws = (unsigned char*)(GAS unsigned char*)kp[31];
    ConvD d; int t, nblk;
    if (T < 32768) { const int j = T >> 13; t = T & 8191;
        const int lay = (j < 2) ? l : 3 - l;
        if ((j & 1) == 0) { d.W = (const float*)(const GAS float*)kp[28] + (size_t)lay * D * FF; d.ldw = FF; nblk = FF / 32; d.ldt = D; d.sc = (const float*)(const GAS float*)kp[2] + (size_t)lay * D; d.smode = 1;
            d.WT = (bf16_t*)(ws + (j < 2 ? WS_WUP01 + (size_t)l * D * FF * 2 : (l == 0 ? WS_WUP3 : WS_WUP2))); }
        else { d.W = (const float*)(const GAS float*)kp[29] + (size_t)lay * D * FF; d.ldw = D; nblk = D / 32; d.ldt = FF; d.sc = nullptr; d.smode = 0;
            d.WT = (bf16_t*)(ws + (j < 2 ? WS_WDN01 + (size_t)l * D * FF * 2 : (l == 0 ? WS_WDN3 : WS_WDN2))); }
        if ((j & 1) && ((F8_M3_MASK >> lay) & 1)) { d.smode = 3; d.sc = (const float*)((const unsigned*)(ws + WS_CTL) + CW_WAMAX + lay); }
    } else { const int j = (T - 32768) >> 11; t = T & 2047; nblk = D / 32; d.ldt = D; d.ldw = D; d.sc = nullptr; d.smode = 0;
        if (j == 0) { d.W = (const float*)(const GAS float*)kp[26]; d.WT = (bf16_t*)(ws + WS_WQK); }
        else if (j == 1) { d.W = (const float*)(const GAS float*)kp[24]; d.ldw = KVF_LD; d.WT = (bf16_t*)(ws + WS_WQK) + (size_t)D * D; }
        else if (j == 2) { d.W = (const float*)(const GAS float*)kp[24] + D; d.ldw = KVF_LD; d.WT = (bf16_t*)(ws + WS_WV); }
        else if (j == 3) { d.W = (const float*)(const GAS float*)kp[26] + (size_t)D * D; d.WT = (bf16_t*)(ws + WS_WQ3); d.sc = (const float*)(const GAS float*)kp[1] + (size_t)3 * D; d.smode = 1; }
        else { d.W = (const float*)(const GAS float*)kp[27] + (size_t)(j - 4) * D * D; d.WT = (bf16_t*)(ws + WS_WFO) + (size_t)(j - 4) * D * D; }
    }
    const int kb = t / nblk, nb = t % nblk;
    d.W += (size_t)(64 * kb) * d.ldw + 32 * nb;
    if (d.smode == 3) d.WT = (bf16_t*)((unsigned char*)d.WT + (size_t)(32 * nb) * d.ldt + 64 * kb);
    else { d.WT += (size_t)(32 * nb) * d.ldt + 64 * kb; if (d.smode) d.sc += 64 * kb; }
    return d;
}
__device__ __forceinline__ int c1_conv_split(int l, int G) { const int tot = c1_conv_ntiles(l); return (G > RH * 4) ? (tot < C2_CONV_FROM ? tot : C2_CONV_FROM) : tot; }
__device__ __forceinline__ void c1_conv_range(KP kp, int l, int t0, int t1, int stride, LAS unsigned* scr, int lane) {
    f32x4 va[8], vb[8];
    int T = t0;
    if (T < t1) { const ConvD d_ = c1_conv_desc(kp, l, T); conv_issue(va, d_.W, d_.ldw, lane, d_.smode == 3); }
    while (T < t1) {
        const int T2 = T + stride, T3 = T2 + stride;
        if (T2 < t1) { const ConvD d_ = c1_conv_desc(kp, l, T2); conv_issue(vb, d_.W, d_.ldw, lane, d_.smode == 3); }
        { const ConvD d_ = c1_conv_desc(kp, l, T); conv_finish(va, d_.WT, d_.ldt, d_.sc, d_.smode, scr, lane); }
        if (T2 < t1) {
            if (T3 < t1) { const ConvD d_ = c1_conv_desc(kp, l, T3); conv_issue(va, d_.W, d_.ldw, lane, d_.smode == 3); }
            const ConvD d_ = c1_conv_desc(kp, l, T2); conv_finish(vb, d_.WT, d_.ldt, d_.sc, d_.smode, scr, lane);
        }
        T = T3;
    }
}
namespace ck {
constexpr int CB = 9216, CST = 144;
enum { L_A = 0, L_AT = 1, L_B = 2, L_K = 3, L_R = 4, L_VT = 5, L_KHT = 6, L_BHT = 7, L_P0 = 8, L_PT0 = 9, L_NT0 = 10, L_AAK = 11, L_ARK = 12, L_ARB = 13,
       L_P1 = 2, L_PT1 = 3, L_NT1 = 7, L_N = 7, L_X1T = 8, L_WT = 2, L_U0T = 10, L_BHT2 = 11 };
constexpr int TOT_OFF = 8 * CB;
constexpr int CONV_OFF = 14 * CB;

__device__ __forceinline__ float rl(float v, int l) { return __builtin_bit_cast(float, __builtin_amdgcn_readlane(__builtin_bit_cast(int, v), l)); }
__device__ __forceinline__ float wsum(float v) {
    v += dpp_f(v, 0); v += dpp_f(v, 1); v += dpp_f(v, 2); v += dpp_f(v, 3);
    return (rl(v, 0) + rl(v, 16)) + (rl(v, 32) + rl(v, 48));
}
__device__ __forceinline__ unsigned short bf1(float x) { return (unsigned short)(cvt_pk_bf16(x, 0.f) & 0xffffu); }
__device__ __forceinline__ float bf2f(unsigned short h) { return __builtin_bit_cast(float, (unsigned)h << 16); }

__device__ __forceinline__ void mm(const LAS unsigned char* Ab, const LAS unsigned char* Bb, int rt, int ct0, int lr, int q, f32x4 (&acc)[2]) {
    const LAS unsigned char* ap = Ab + (16 * rt + lr) * CST + q * 16;
    const bf16x8 a0 = *(const LAS bf16x8*)ap, a1 = *(const LAS bf16x8*)(ap + 64);
#pragma unroll
    for (int c = 0; c < 2; ++c) { const LAS unsigned char* bp = Bb + (16 * (ct0 + c) + lr) * CST + q * 16;
        const bf16x8 b0 = *(const LAS bf16x8*)bp, b1 = *(const LAS bf16x8*)(bp + 64);
        acc[c] = __builtin_amdgcn_mfma_f32_16x16x32_bf16(a0, b0, acc[c], 0, 0, 0);
        acc[c] = __builtin_amdgcn_mfma_f32_16x16x32_bf16(a1, b1, acc[c], 0, 0, 0); }
}
__device__ __forceinline__ void ldf(bf16x8 (&f)[2], const LAS unsigned char* buf, int tile, int lr, int q) {
    const LAS unsigned char* p = buf + (16 * tile + lr) * CST + q * 16; f[0] = *(const LAS bf16x8*)p; f[1] = *(const LAS bf16x8*)(p + 64);
}
__device__ __forceinline__ f32x4 mma(const bf16x8 (&a)[2], const bf16x8 (&b)[2], f32x4 acc) {
    acc = __builtin_amdgcn_mfma_f32_16x16x32_bf16(a[0], b[0], acc, 0, 0, 0); return __builtin_amdgcn_mfma_f32_16x16x32_bf16(a[1], b[1], acc, 0, 0, 0);
}
__device__ __forceinline__ void wr_rm(LAS unsigned char* buf, int rt, int ct, int lr, int q, f32x4 v) {
#pragma unroll
    for (int r = 0; r < 4; ++r) *(LAS unsigned short*)(buf + (16 * rt + 4 * q + r) * CST + (16 * ct + lr) * 2) = bf1(v[r]);
}
__device__ __forceinline__ void wr_t(LAS unsigned char* buf, int rt, int ct, int lr, int q, f32x4 v) {
    *(LAS u32x2*)(buf + (16 * ct + lr) * CST + (16 * rt + 4 * q) * 2) = (u32x2){cvt_pk_bf16(v[0], v[1]), cvt_pk_bf16(v[2], v[3])};
}
__device__ __forceinline__ f32x4 mask_tile(f32x4 v, int rt, int ct, int lr, int q, bool incl) {
    const int col = 16 * ct + lr;
#pragma unroll
    for (int r = 0; r < 4; ++r) { const int row = 16 * rt + 4 * q + r; const bool keep = incl ? (col <= row) : (col < row); v[r] = keep ? v[r] : 0.f; }
    return v;
}

__device__ __forceinline__ int unit_of(int it) { return (it % RH) * NCHUNK + it / RH; }
struct Raw { float r[8], k[8], v[8], w[8], a[8]; };
__device__ __forceinline__ void load_raw(Raw& R, const bf16_t* r, const bf16_t* k, const bf16_t* v, const float* wld, const bf16_t* a, int unit, int wid, int lane) {
    const int hd = unit / NCHUNK, n = unit % NCHUNK;
#pragma unroll
    for (int j = 0; j < 8; ++j) { const size_t o = (size_t)(n * 64 + wid * 8 + j) * D + hd * RN + lane;
        R.r[j] = bf2f(r[o]); R.k[j] = bf2f(k[o]); R.v[j] = bf2f(v[o]); R.w[j] = (float)((const _Float16*)wld)[o]; R.a[j] = bf2f(a[o]); }
}

__device__ __forceinline__ void phase_c1(const bf16_t* r, const bf16_t* k, const bf16_t* v, const float* wld, const bf16_t* a, const float* k_k, const float* k_a, const float* r_k,
                                         bf16_t* CW, bf16_t* CBH, bf16_t* CR, bf16_t* CARB, bf16_t* CU0, bf16_t* CKV, bf16_t* CY0, float* CGC, float* BS,
                                         LAS unsigned char* lds, int bx, int G, int tid, KP kp, int l) {
    const int lane = tid & 63, wid = __builtin_amdgcn_readfirstlane(tid >> 6), lr = lane & 15, q = lane >> 4;
    const int rt = wid >> 1, ct0 = 2 * (wid & 1);
    LAS float* tot = (LAS float*)(lds + TOT_OFF);
    LAS unsigned* cscr = (LAS unsigned*)(lds + CONV_OFF + wid * CONV_SCR);
    const int gw = bx * 8 + wid, NGW = G * 8, cnt_ = RIDE ? c1_conv_split(l, G) : 0, CR_ = (cnt_ + NGW - 1) / NGW, NS_ = 2 * (NUNIT / G), CRc = CR_ < NS_ ? CR_ : NS_;
    f32x4 cv[8]; int cpend = -1, cslot = 0, cacc = 0, crd = 0;
#define C1_CONV_HOOK() do { \
        if (cpend >= 0) { const ConvD d_ = c1_conv_desc(kp, l, cpend); conv_finish(cv, d_.WT, d_.ldt, d_.sc, d_.smode, cscr, lane); cpend = -1; } \
        if (cslot < NS_) { cacc += CRc; if (cacc >= NS_) { cacc -= NS_; const int T_ = crd * NGW + gw; ++crd; \
            if (T_ < cnt_) { const ConvD d_ = c1_conv_desc(kp, l, T_); conv_issue(cv, d_.W, d_.ldw, lane, d_.smode == 3); cpend = T_; } } } \
        ++cslot; } while (0)
#define LB(i) (lds + (i) * CB)
#define C1_BAR() do { asm volatile("s_waitcnt lgkmcnt(0)" ::: "memory"); __builtin_amdgcn_s_barrier(); asm volatile("" ::: "memory"); } while (0)
    Raw R;
    if (bx < NUNIT) load_raw(R, r, k, v, wld, a, unit_of(bx), wid, lane);
    for (int it_ = bx; it_ < NUNIT; it_ += G) { const int unit = unit_of(it_);
        const int hd = unit / NCHUNK, n = unit % NCHUNK, ch = hd * RN + lane;
        const float kkc = k_k[ch], kac = k_a[ch], rkc = r_k[ch];
        float cl[8]; float run = 0.f;
#pragma unroll
        for (int j = 0; j < 8; ++j) { run += R.w[j] * LOG2E; cl[j] = run; }
        tot[wid * 64 + lane] = run;
        C1_BAR();
        float base = 0.f, clC = 0.f;
#pragma unroll
        for (int w = 0; w < 8; ++w) { const float t_ = tot[w * 64 + lane]; clC += t_; base += (w < wid) ? t_ : 0.f; }
        float atT[8], khT[8], bhT[8]; u32x4 bhP;
#pragma unroll
        for (int j = 0; j < 8; ++j) {
            const float c_ = cl[j] + base;
            const float kkv = R.k[j] * kkc; const float ss = wsum(kkv * kkv); const float kkn = kkv * (1.0f / fmaxf(sqrtf(ss), 1e-12f));
            const float b_ = kkn * R.a[j], kp = R.k[j] * (1.0f + (R.a[j] - 1.0f) * kac);
            const float bon = wsum(R.r[j] * kp * rkc);
            if (lane == 0) BS[(size_t)(n * 64 + wid * 8 + j) * RH + hd] = bon;
            const float e_m1 = __builtin_amdgcn_exp2f(c_ - R.w[j] * LOG2E), e_n = __builtin_amdgcn_exp2f(-c_), e_p = __builtin_amdgcn_exp2f(c_), e_c = __builtin_amdgcn_exp2f(clC - c_);
            const float at = -kkn * e_m1; atT[j] = at; khT[j] = kp * e_c; bhT[j] = b_ * e_c;
            const int ro = (wid * 8 + j) * CST + lane * 2;
            *(LAS unsigned short*)(LB(L_A) + ro) = bf1(at);
            *(LAS unsigned short*)(LB(L_B) + ro) = bf1(b_ * e_n);
            *(LAS unsigned short*)(LB(L_K) + ro) = bf1(kp * e_n);
            *(LAS unsigned short*)(LB(L_R) + ro) = bf1(R.r[j] * e_p);
        }
        {
            const int to = lane * CST + wid * 16;
            *(LAS u32x4*)(LB(L_AT) + to) = (u32x4){cvt_pk_bf16(atT[0], atT[1]), cvt_pk_bf16(atT[2], atT[3]), cvt_pk_bf16(atT[4], atT[5]), cvt_pk_bf16(atT[6], atT[7])};
            *(LAS u32x4*)(LB(L_VT) + to) = (u32x4){cvt_pk_bf16(R.v[0], R.v[1]), cvt_pk_bf16(R.v[2], R.v[3]), cvt_pk_bf16(R.v[4], R.v[5]), cvt_pk_bf16(R.v[6], R.v[7])};
            *(LAS u32x4*)(LB(L_KHT) + to) = (u32x4){cvt_pk_bf16(khT[0], khT[1]), cvt_pk_bf16(khT[2], khT[3]), cvt_pk_bf16(khT[4], khT[5]), cvt_pk_bf16(khT[6], khT[7])};
            bhP = (u32x4){cvt_pk_bf16(bhT[0], bhT[1]), cvt_pk_bf16(bhT[2], bhT[3]), cvt_pk_bf16(bhT[4], bhT[5]), cvt_pk_bf16(bhT[6], bhT[7])};
            if (wid == 0) CGC[(size_t)unit * 64 + lane] = __builtin_amdgcn_exp2f(clC);
        }
        C1_BAR();
        C1_CONV_HOOK();
        if (it_ + G < NUNIT) load_raw(R, r, k, v, wld, a, unit_of(it_ + G), wid, lane);
        f32x4 nreg[2], preg[2];
        {
            bf16x8 fA[2], fR[2], fB[2][2], fK[2][2];
            ldf(fA, LB(L_A), rt, lr, q); ldf(fR, LB(L_R), rt, lr, q);
#pragma unroll
            for (int c = 0; c < 2; ++c) { ldf(fB[c], LB(L_B), ct0 + c, lr, q); ldf(fK[c], LB(L_K), ct0 + c, lr, q); }
            const f32x4 z4 = (f32x4){0.f, 0.f, 0.f, 0.f};
#pragma unroll
            for (int c = 0; c < 2; ++c) { const f32x4 m = mask_tile(mma(fA, fB[c], z4), rt, ct0 + c, lr, q, false); nreg[c] = m; preg[c] = m;
                wr_rm(LB(L_P0), rt, ct0 + c, lr, q, m); wr_t(LB(L_PT0), rt, ct0 + c, lr, q, m); wr_t(LB(L_NT0), rt, ct0 + c, lr, q, m); }
#pragma unroll
            for (int c = 0; c < 2; ++c) wr_rm(LB(L_AAK), rt, ct0 + c, lr, q, mask_tile(mma(fA, fK[c], z4), rt, ct0 + c, lr, q, false));
#pragma unroll
            for (int c = 0; c < 2; ++c) wr_rm(LB(L_ARB), rt, ct0 + c, lr, q, mask_tile(mma(fR, fB[c], z4), rt, ct0 + c, lr, q, true));
#pragma unroll
            for (int c = 0; c < 2; ++c) wr_rm(LB(L_ARK), rt, ct0 + c, lr, q, mask_tile(mma(fR, fK[c], z4), rt, ct0 + c, lr, q, true));
        }
        C1_BAR();
        {
            f32x4 acc[2]; acc[0] = acc[1] = (f32x4){0.f, 0.f, 0.f, 0.f}; mm(LB(L_P0), LB(L_PT0), rt, ct0, lr, q, acc);
#pragma unroll
            for (int c = 0; c < 2; ++c) { preg[c] = acc[c]; wr_rm(LB(L_P1), rt, ct0 + c, lr, q, acc[c]); wr_t(LB(L_PT1), rt, ct0 + c, lr, q, acc[c]); }
        }
        C1_BAR();
#pragma unroll
        for (int i = 1; i <= 4; ++i) {
            LAS unsigned char* Pc = (i & 1) ? LB(L_P1) : LB(L_P0); LAS unsigned char* PTc = (i & 1) ? LB(L_PT1) : LB(L_PT0);
            LAS unsigned char* NTp = (i & 1) ? LB(L_NT0) : LB(L_NT1); LAS unsigned char* NTn = (i & 1) ? LB(L_NT1) : LB(L_NT0);
            LAS unsigned char* Pn = (i & 1) ? LB(L_P0) : LB(L_P1); LAS unsigned char* PTn = (i & 1) ? LB(L_PT0) : LB(L_PT1);
            bf16x8 fP[2], fN[2][2], fT[2][2]; ldf(fP, Pc, rt, lr, q);
#pragma unroll
            for (int c = 0; c < 2; ++c) { ldf(fN[c], NTp, ct0 + c, lr, q); ldf(fT[c], PTc, ct0 + c, lr, q); }
            f32x4 acc[2], ac2[2];
#pragma unroll
            for (int c = 0; c < 2; ++c) { acc[c] = mma(fP, fN[c], (f32x4){0.f, 0.f, 0.f, 0.f}); ac2[c] = mma(fP, fT[c], (f32x4){0.f, 0.f, 0.f, 0.f}); }
#pragma unroll
            for (int c = 0; c < 2; ++c) { nreg[c] = nreg[c] + preg[c] + acc[c]; wr_t(NTn, rt, ct0 + c, lr, q, nreg[c]);
                preg[c] = ac2[c]; wr_rm(Pn, rt, ct0 + c, lr, q, ac2[c]); wr_t(PTn, rt, ct0 + c, lr, q, ac2[c]); }
            C1_BAR();
        }
        C1_CONV_HOOK();
        f32x4 x1[2];
        {
            f32x4 acc[2]; acc[0] = acc[1] = (f32x4){0.f, 0.f, 0.f, 0.f}; mm(LB(L_P1), LB(L_NT0), rt, ct0, lr, q, acc);
#pragma unroll
            for (int c = 0; c < 2; ++c) { nreg[c] = nreg[c] + preg[c] + acc[c]; wr_rm(LB(L_N), rt, ct0 + c, lr, q, nreg[c]); }
            bf16x8 fV[2][2], fAk[2]; ldf(fAk, LB(L_AAK), rt, lr, q);
#pragma unroll
            for (int c = 0; c < 2; ++c) ldf(fV[c], LB(L_VT), ct0 + c, lr, q);
#pragma unroll
            for (int c = 0; c < 2; ++c) x1[c] = mma(fAk, fV[c], (f32x4){0.f, 0.f, 0.f, 0.f});
#pragma unroll
            for (int c = 0; c < 2; ++c) wr_t(LB(L_X1T), rt, ct0 + c, lr, q, x1[c]);
        }
        C1_BAR();
        {
            mm(LB(L_N), LB(L_X1T), rt, ct0, lr, q, x1);
#pragma unroll
            for (int c = 0; c < 2; ++c) wr_t(LB(L_U0T), rt, ct0 + c, lr, q, x1[c]);
            f32x4 acc[2];
#pragma unroll
            for (int c = 0; c < 2; ++c) { const u32x2 w_ = *(const LAS u32x2*)(LB(L_A) + (16 * (ct0 + c) + lr) * CST + (16 * rt + 4 * q) * 2);
                acc[c] = (f32x4){__builtin_bit_cast(float, w_.x << 16), __builtin_bit_cast(float, w_.x & 0xffff0000u), __builtin_bit_cast(float, w_.y << 16), __builtin_bit_cast(float, w_.y & 0xffff0000u)}; }
            mm(LB(L_AT), LB(L_N), rt, ct0, lr, q, acc);
#pragma unroll
            for (int c = 0; c < 2; ++c) wr_rm(LB(L_WT), rt, ct0 + c, lr, q, acc[c]);
            *(LAS u32x4*)(LB(L_BHT2) + lane * CST + wid * 16) = bhP;
        }
        C1_BAR();
        {
            int lr_ = lr, q_ = q, rt_ = rt, ct_ = ct0; asm volatile("" : "+v"(lr_), "+v"(q_), "+s"(rt_), "+s"(ct_));
            f32x4 acc[2];
#pragma unroll
            for (int c = 0; c < 2; ++c) { const u32x2 w_ = *(const LAS u32x2*)(LB(L_R) + (16 * (ct_ + c) + lr_) * CST + (16 * rt_ + 4 * q_) * 2);
                acc[c] = (f32x4){__builtin_bit_cast(float, w_.x << 16), __builtin_bit_cast(float, w_.x & 0xffff0000u), __builtin_bit_cast(float, w_.y << 16), __builtin_bit_cast(float, w_.y & 0xffff0000u)}; }
            mm(LB(L_WT), LB(L_ARB), rt_, ct_, lr_, q_, acc);
#pragma unroll
            for (int c = 0; c < 2; ++c) *(u32x2*)((unsigned char*)CR + (size_t)unit * 8192 + (16 * (ct_ + c) + lr_) * 128 + (16 * rt_ + 4 * q_) * 2) = (u32x2){cvt_pk_bf16(acc[c][0], acc[c][1]), cvt_pk_bf16(acc[c][2], acc[c][3])};
            f32x4 y0a[2]; y0a[0] = y0a[1] = (f32x4){0.f, 0.f, 0.f, 0.f};
            mm(LB(L_VT), LB(L_ARK), rt_, ct_, lr_, q_, y0a); mm(LB(L_U0T), LB(L_ARB), rt_, ct_, lr_, q_, y0a);
#pragma unroll
            for (int c = 0; c < 2; ++c) *(u32x2*)(CY0 + (size_t)unit * 4096 + (16 * (ct_ + c) + lr_) * 64 + 16 * rt_ + 4 * q_) = (u32x2){cvt_pk_bf16(y0a[c][0], y0a[c][1]), cvt_pk_bf16(y0a[c][2], y0a[c][3])};
            acc[0] = acc[1] = (f32x4){0.f, 0.f, 0.f, 0.f}; mm(LB(L_WT), LB(L_BHT2), rt_, ct_, lr_, q_, acc);
#pragma unroll
            for (int c = 0; c < 2; ++c) *(u32x2*)((unsigned char*)CW + (size_t)unit * 8192 + (16 * (ct_ + c) + lr_) * 128 + (16 * rt_ + 4 * q_) * 2) = (u32x2){cvt_pk_bf16(acc[c][0], acc[c][1]), cvt_pk_bf16(acc[c][2], acc[c][3])};
            acc[0] = acc[1] = (f32x4){0.f, 0.f, 0.f, 0.f}; mm(LB(L_KHT), LB(L_VT), rt_, ct_, lr_, q_, acc); mm(LB(L_BHT2), LB(L_U0T), rt_, ct_, lr_, q_, acc);
#pragma unroll
            for (int c = 0; c < 2; ++c) *(u32x2*)(CKV + (size_t)unit * 4096 + (16 * (ct_ + c) + lr_) * 64 + 16 * rt_ + 4 * q_) = (u32x2){cvt_pk_bf16(acc[c][0], acc[c][1]), cvt_pk_bf16(acc[c][2], acc[c][3])};
        }
        C1_BAR();
    }
    if (cpend >= 0) { const ConvD d_ = c1_conv_desc(kp, l, cpend); conv_finish(cv, d_.WT, d_.ldt, d_.sc, d_.smode, cscr, lane); }
    for (int rd = CRc; rd < CR_; ++rd) { const int T_ = rd * NGW + gw;
        if (T_ < cnt_) { const ConvD d_ = c1_conv_desc(kp, l, T_); conv_issue(cv, d_.W, d_.ldw, lane, d_.smode == 3); conv_finish(cv, d_.WT, d_.ldt, d_.sc, d_.smode, cscr, lane); } }
#undef C1_CONV_HOOK
#undef LB
#undef C1_BAR
}

constexpr int C2_SLOT = 21504, C2_W = 0, C2_BH = 8192, C2_U0 = 16384, C2_KV = 18432, C2_GC = 20480, C2_NSLOT = 7;
__device__ __forceinline__ void c2_issue(const unsigned char* CW, const unsigned char* CBH, const unsigned char* CU0, const unsigned char* CKV, const unsigned char* CGC,
                                         LAS unsigned char* slot, int unit, int vs, int wid, int lane) {
    if (wid >= 1 && wid <= 2) { const unsigned char* src = CW + (size_t)unit * 8192; LAS unsigned char* dst = slot + C2_W; (void)CBH; (void)CU0;
        const int u0 = ((wid - 1) & 1) * 4; const int so = (lane >> 3) * 128 + (((lane & 7) ^ (lane >> 3)) << 4);
#pragma unroll
        for (int i = 0; i < 4; ++i) __builtin_amdgcn_global_load_lds((const unsigned*)(src + (u0 + i) * 1024 + so), (LAS unsigned*)(dst + (u0 + i) * 1024), 16, 0, 0);
    } else if (wid == 5) {
        __builtin_amdgcn_global_load_lds((const unsigned*)(CGC + (size_t)unit * 256 + lane * 16), (LAS unsigned*)(slot + C2_GC), 16, 0, 0);
    } else if (wid == 6) { const unsigned char* src = CKV + (size_t)unit * 8192 + vs * 2048; const int so = (lane >> 3) * 128 + (((lane & 7) ^ (lane >> 3)) << 4);
#pragma unroll
        for (int i = 0; i < 2; ++i) __builtin_amdgcn_global_load_lds((const unsigned*)(src + i * 1024 + so), (LAS unsigned*)(slot + C2_KV + i * 1024), 16, 0, 0);
    }
}
__device__ __forceinline__ void phase_c2(const bf16_t* CW, const bf16_t* CBH, const bf16_t* CU0, const bf16_t* CKV, const float* CGC, bf16_t* CUT, bf16_t* CS0,
                                         LAS unsigned char* lds, int task, int tid) {
    const int lane = tid & 63, wid = __builtin_amdgcn_readfirstlane(tid >> 6), lr = lane & 15, q = lane >> 4;
    const int hd = (task & 7) * 4 + (task >> 5), vs = (task >> 3) & 3, ubase = hd * NCHUNK;
    const unsigned char* pW = (const unsigned char*)CW; const unsigned char* pBH = (const unsigned char*)CBH; const unsigned char* pU0 = (const unsigned char*)CU0;
    const unsigned char* pKV = (const unsigned char*)CKV; const unsigned char* pGC = (const unsigned char*)CGC;
#define C2_WAITV() do { if (wid >= 1 && wid <= 2) asm volatile("s_waitcnt vmcnt(20)" ::: "memory"); else if (wid == 5) asm volatile("s_waitcnt vmcnt(5)" ::: "memory"); \
                        else if (wid == 6) asm volatile("s_waitcnt vmcnt(10)" ::: "memory"); } while (0)
#pragma unroll
    for (int m = 0; m < C2_NSLOT - 1; ++m) c2_issue(pW, pBH, pU0, pKV, pGC, lds + m * C2_SLOT, ubase + m, vs, wid, lane);
    f32x4 sreg[4]; bf16x8 sfrag[2];
#pragma unroll
    for (int i = 0; i < 4; ++i) sreg[i] = (f32x4){0.f, 0.f, 0.f, 0.f};
    sfrag[0] = sfrag[1] = (bf16x8){0, 0, 0, 0, 0, 0, 0, 0};
    for (int n = 0; n < NCHUNK; ++n) {
        C2_WAITV();
        asm volatile("s_waitcnt lgkmcnt(0)" ::: "memory");
        __builtin_amdgcn_s_barrier();
        asm volatile("" ::: "memory");
        { const int m = (n + 6 < NCHUNK) ? n + 6 : NCHUNK - 1; c2_issue(pW, pBH, pU0, pKV, pGC, lds + ((n + 6) % C2_NSLOT) * C2_SLOT, ubase + m, vs, wid, lane); }
        if (wid == 0) {
            const LAS unsigned char* sl = lds + (n % C2_NSLOT) * C2_SLOT;
            const size_t uo = (size_t)(ubase + n) * 8192 + (size_t)(16 * vs + lr) * 128;
            bf16x8 mf[4][2]; f32x4 kvv[4], gcv[4];
#pragma unroll
            for (int ct = 0; ct < 4; ++ct) { const int row = 16 * ct + lr;
                gcv[ct] = *(const LAS f32x4*)(sl + C2_GC + (16 * ct + 4 * q) * 4);
                { const int chn = 2 * ct + (q >> 1); const u32x2 w_ = *(const LAS u32x2*)(sl + C2_KV + lr * 128 + ((chn ^ (lr & 7)) << 4) + (q & 1) * 8);
                  kvv[ct] = (f32x4){__builtin_bit_cast(float, w_.x << 16), __builtin_bit_cast(float, w_.x & 0xffff0000u), __builtin_bit_cast(float, w_.y << 16), __builtin_bit_cast(float, w_.y & 0xffff0000u)}; }
#pragma unroll
                for (int g = 0; g < 2; ++g) { const int c0 = 4 * g + (q >> 1);
                    const u32x2 lo = *(const LAS u32x2*)(sl + C2_W + row * 128 + ((c0 ^ (row & 7)) << 4) + (q & 1) * 8), hi = *(const LAS u32x2*)(sl + C2_W + row * 128 + (((c0 + 2) ^ (row & 7)) << 4) + (q & 1) * 8);
                    mf[ct][g] = __builtin_bit_cast(bf16x8, (u32x4){lo.x, lo.y, hi.x, hi.y}); } }
#pragma unroll
            for (int g = 0; g < 2; ++g) { const u32x4 w_ = __builtin_bit_cast(u32x4, sfrag[g]);
                *(u32x2*)((unsigned char*)CS0 + uo + (32 * g + 4 * q) * 2) = (u32x2){w_.x, w_.y}; *(u32x2*)((unsigned char*)CS0 + uo + (32 * g + 16 + 4 * q) * 2) = (u32x2){w_.z, w_.w}; }
#pragma unroll
            for (int ct = 0; ct < 4; ++ct) {
                f32x4 acc = sreg[ct] * gcv[ct] + kvv[ct];
#pragma unroll
                for (int g = 0; g < 2; ++g) acc = __builtin_amdgcn_mfma_f32_16x16x32_bf16(mf[ct][g], sfrag[g], acc, 0, 0, 0);
                sreg[ct] = acc;
            }
            (void)CUT;
#pragma unroll
            for (int g = 0; g < 2; ++g) sfrag[g] = __builtin_bit_cast(bf16x8, (u32x4){cvt_pk_bf16(sreg[2 * g][0], sreg[2 * g][1]), cvt_pk_bf16(sreg[2 * g][2], sreg[2 * g][3]),
                                                                                       cvt_pk_bf16(sreg[2 * g + 1][0], sreg[2 * g + 1][1]), cvt_pk_bf16(sreg[2 * g + 1][2], sreg[2 * g + 1][3])});
        }
    }
#undef C2_WAITV
    asm volatile("s_waitcnt vmcnt(0)" ::: "memory");
    __syncthreads();
}

__device__ __forceinline__ void phase_c3(const bf16_t* CS0, const bf16_t* CUT, const bf16_t* CR, const bf16_t* CARB, const bf16_t* CY0, const float* BS, const bf16_t* v, const bf16_t* g,
                                         const float* lnw, const float* lnb, bf16_t* yg, int bx, int G, int tid) {
    const int lane = tid & 63, wid = __builtin_amdgcn_readfirstlane(tid >> 6), lr = lane & 15, q = lane >> 4, tt = wid & 3;
    for (int it_ = bx * 2 + (wid >> 2); it_ < NUNIT; it_ += 2 * G) { const int unit = unit_of(it_);
        const int hd = unit / NCHUNK, n = unit % NCHUNK, t = n * 64 + 16 * tt + lr;
        const size_t ub = (size_t)unit * 4096;
        bf16x8 br[2]; (void)CUT; (void)CARB;
#pragma unroll
        for (int ks = 0; ks < 2; ++ks) br[ks] = *(const bf16x8*)(CR + ub + (16 * tt + lr) * 64 + 32 * ks + 8 * q);
        f32x4 acc[4];
#pragma unroll
        for (int vt = 0; vt < 4; ++vt) {
            { const u32x2 w_ = *(const u32x2*)(CY0 + ub + (16 * tt + lr) * 64 + 16 * vt + 4 * q);
              acc[vt] = (f32x4){__builtin_bit_cast(float, w_.x << 16), __builtin_bit_cast(float, w_.x & 0xffff0000u), __builtin_bit_cast(float, w_.y << 16), __builtin_bit_cast(float, w_.y & 0xffff0000u)}; }
#pragma unroll
            for (int ks = 0; ks < 2; ++ks) {
                const bf16x8 as = *(const bf16x8*)(CS0 + ub + (16 * vt + lr) * 64 + 32 * ks + 8 * q);
                acc[vt] = __builtin_amdgcn_mfma_f32_16x16x32_bf16(as, br[ks], acc[vt], 0, 0, 0);
            }
        }
        float s = 0.f;
#pragma unroll
        for (int vt = 0; vt < 4; ++vt) s += (acc[vt][0] + acc[vt][1]) + (acc[vt][2] + acc[vt][3]);
        s += __shfl_xor(s, 16); s += __shfl_xor(s, 32);
        const float mu = s * (1.0f / RN);
        float s2 = 0.f;
#pragma unroll
        for (int vt = 0; vt < 4; ++vt) { acc[vt] = acc[vt] - mu; s2 += (acc[vt][0] * acc[vt][0] + acc[vt][1] * acc[vt][1]) + (acc[vt][2] * acc[vt][2] + acc[vt][3] * acc[vt][3]); }
        s2 += __shfl_xor(s2, 16); s2 += __shfl_xor(s2, 32);
        const float rstd = rsqrtf(s2 * (1.0f / RN) + LNX_EPS);
        const float bon = BS[(size_t)t * RH + hd];
#pragma unroll
        for (int vt = 0; vt < 4; ++vt) { const int c = hd * RN + 16 * vt + 4 * q; const size_t o = (size_t)t * D + c;
            const f32x4 w_ = *(const f32x4*)(lnw + c), b_ = *(const f32x4*)(lnb + c); const u32x2 vw = *(const u32x2*)(v + o); const u32x2 gg = *(const u32x2*)(g + o);
            const f32x4 vv = (f32x4){__builtin_bit_cast(float, vw.x << 16), __builtin_bit_cast(float, vw.x & 0xffff0000u), __builtin_bit_cast(float, vw.y << 16), __builtin_bit_cast(float, vw.y & 0xffff0000u)};
            const f32x4 gv = (f32x4){__builtin_bit_cast(float, gg.x << 16), __builtin_bit_cast(float, gg.x & 0xffff0000u), __builtin_bit_cast(float, gg.y << 16), __builtin_bit_cast(float, gg.y & 0xffff0000u)};
            const f32x4 o_ = (acc[vt] * rstd * w_ + b_ + vv * bon) * gv;
            *(u32x2*)(yg + o) = (u32x2){cvt_pk_bf16(o_[0], o_[1]), cvt_pk_bf16(o_[2], o_[3])}; }
    }
}
}

constexpr int ATT_KS = 272, ATT_VS = 136, ATT_KB = 64 * ATT_KS, ATT_VB = 128 * ATT_VS, ATT_BUF = ATT_KB + ATT_VB + 256;
constexpr int CW_KMAX = 8192;
constexpr float ATT_SKIP = 128.f;
constexpr int AT_K = 0, AT_V = 16384, AT_C = 32768, AT_SLOT = 33792;
__device__ __forceinline__ void att_issue(const bf16_t* kb_, const bf16_t* vt_, const float* cs2, LAS unsigned char* slot, int hd, int kt, int wid, int lane) {
#pragma unroll
    for (int j = 0; j < 2; ++j) { const int p = 2 * wid + j, row = 4 * p + (lane >> 4);
        __builtin_amdgcn_global_load_lds((const unsigned*)((const unsigned char*)(kb_ + (size_t)(kt * 64 + row) * D + hd * FD) + (((lane & 15) ^ (row & 15)) << 4)), (LAS unsigned*)(slot + AT_K + p * 1024), 16, 0, 0); }
#pragma unroll
    for (int j = 0; j < 2; ++j) { const int p = 2 * wid + j, row = 8 * p + (lane >> 3);
        __builtin_amdgcn_global_load_lds((const unsigned*)((const unsigned char*)(vt_ + (size_t)(hd * FD + row) * S + kt * 64) + (((lane & 7) ^ ((row >> 1) & 7)) << 4)), (LAS unsigned*)(slot + AT_V + p * 1024), 16, 0, 0); }
    if (wid == 0) __builtin_amdgcn_global_load_lds((const unsigned*)((const unsigned char*)(cs2 + (size_t)hd * S + kt * 64) + lane * 16), (LAS unsigned*)(slot + AT_C), 16, 0, 0);
}
__device__ __forceinline__ void attn_unit(const bf16_t* qb_, const bf16_t* kb_, const bf16_t* vt_, const float* cs2, const unsigned* kmaxw, bf16_t* ob_, LAS unsigned char* lds,
                                          volatile LAS unsigned* donecnt, int hd, int qblk, int tid) {
    const int lane = tid & 63, wid = __builtin_amdgcn_readfirstlane(tid >> 6), ql = lane & 31, hh = lane >> 5;
    const int q0 = qblk * 256 + wid * 32, qrow = q0 + ql;
    const int ntile = qblk * 4 + 4;
    const int my_last = (q0 + 31) >> 6;
#define AT_WAITV(n_) do { if (wid == 0) asm volatile("s_waitcnt vmcnt(%0)" :: "n"(5 * (n_)) : "memory"); else asm volatile("s_waitcnt vmcnt(%0)" :: "n"(4 * (n_)) : "memory"); } while (0)
    if (tid == 0) *donecnt = 0u;
    att_issue(kb_, vt_, cs2, lds, hd, ntile - 1, wid, lane);
    att_issue(kb_, vt_, cs2, lds + AT_SLOT, hd, (ntile - 2 > 0) ? ntile - 2 : 0, wid, lane);
    int koff_[8], voff_[4];
#pragma unroll
    for (int ks = 0; ks < 8; ++ks) koff_[ks] = ql * 256 + (((2 * ks + hh) ^ (ql & 15)) << 4);
#pragma unroll
    for (int s4 = 0; s4 < 4; ++s4) voff_[s4] = ql * 128 + (((2 * s4 + hh) ^ ((ql >> 1) & 7)) << 4);
    bf16x8 qf[8];
#pragma unroll
    for (int ks = 0; ks < 8; ++ks) qf[ks] = *(const bf16x8*)(qb_ + (size_t)qrow * D + hd * FD + ks * 16 + hh * 8);
    float qs = 0.f;
#pragma unroll
    for (int ks = 0; ks < 8; ++ks)
#pragma unroll
        for (int j = 0; j < 8; ++j) { const float v = __builtin_bit_cast(float, (unsigned)(unsigned short)qf[ks][j] << 16); qs += v * v; }
    qs += __shfl_xor(qs, 32);
    float kmax2 = 0.f;
#pragma unroll
    for (int p = 0; p < 4; ++p) kmax2 += __builtin_bit_cast(float, __hip_atomic_load(kmaxw + hd * 4 + p, __ATOMIC_RELAXED, __HIP_MEMORY_SCOPE_AGENT));
    const float kmax = sqrtf(kmax2);
    const float qk_bound = sqrtf(qs) * kmax * 1.01f + 1.0f;
    f32x16 ot[4];
#pragma unroll
    for (int i = 0; i < 4; ++i)
#pragma unroll
        for (int j = 0; j < 16; ++j) ot[i][j] = 0.f;
    float m_run = -1e30f, l_run = 0.f;
    bool done = false;
    int it = 0;
    for (int kt = ntile - 1; kt >= 0; --kt, ++it) {
        AT_WAITV(1);
        asm volatile("s_waitcnt lgkmcnt(0)" ::: "memory");
        __builtin_amdgcn_s_barrier();
        asm volatile("" ::: "memory");
        if (*donecnt == 8u) break;
        { const int kn = (kt - 2 > 0) ? kt - 2 : 0; att_issue(kb_, vt_, cs2, lds + ((it + 2) % 3) * AT_SLOT, hd, kn, wid, lane); }
        if (kt <= my_last && !done) {
            const LAS unsigned char* kb = lds + (it % 3) * AT_SLOT; const LAS unsigned char* vb = kb + AT_V; const LAS float* cb = (const LAS float*)(kb + AT_C);
            f32x16 st[2];
            bf16x8 af[2][8]; f32x4 ckv[2][4];
#pragma unroll
            for (int kh = 0; kh < 2; ++kh) { const int row = kh * 32 + ql;
#pragma unroll
                for (int ks = 0; ks < 8; ++ks) af[kh][ks] = *(const LAS bf16x8*)(kb + koff_[ks] + kh * 8192);
#pragma unroll
                for (int g4 = 0; g4 < 4; ++g4) ckv[kh][g4] = *(const LAS f32x4*)(cb + kh * 32 + 8 * g4 + 4 * hh); }
#pragma unroll
            for (int kh = 0; kh < 2; ++kh)
#pragma unroll
                for (int g4 = 0; g4 < 4; ++g4)
#pragma unroll
                    for (int e = 0; e < 4; ++e) st[kh][g4 * 4 + e] = ckv[kh][g4][e];
#pragma unroll
            for (int ks = 0; ks < 8; ++ks)
#pragma unroll
                for (int kh = 0; kh < 2; ++kh) st[kh] = __builtin_amdgcn_mfma_f32_32x32x16_bf16(af[kh][ks], qf[ks], st[kh], 0, 0, 0);
            const bool diag = (kt * 64 + 63 > q0);
            float mloc = -__builtin_inff();
            if (diag) {
#pragma unroll
                for (int kh = 0; kh < 2; ++kh)
#pragma unroll
                    for (int g4 = 0; g4 < 4; ++g4)
#pragma unroll
                        for (int e = 0; e < 4; ++e) { const int key = kt * 64 + kh * 32 + 8 * g4 + 4 * hh + e; if (key > qrow) st[kh][g4 * 4 + e] = -__builtin_inff(); }
            }
#pragma unroll
            for (int kh = 0; kh < 2; ++kh)
#pragma unroll
                for (int j = 0; j < 16; ++j) mloc = fmaxf(mloc, st[kh][j]);
            mloc = fmaxf(mloc, __shfl_xor(mloc, 32));
            const float m_new = fmaxf(m_run, mloc);
            const float alpha = __builtin_amdgcn_exp2f(m_run - m_new);
            m_run = m_new;
            const f32x2_t nm2 = {-m_new, -m_new}; f32x2_t ps2 = {0.f, 0.f};
#pragma unroll
            for (int kh = 0; kh < 2; ++kh)
#pragma unroll
                for (int j = 0; j < 16; j += 2) { const f32x2_t d2 = (f32x2_t){st[kh][j], st[kh][j + 1]} + nm2;
                    const f32x2_t p2 = {__builtin_amdgcn_exp2f(d2[0]), __builtin_amdgcn_exp2f(d2[1])}; st[kh][j] = p2[0]; st[kh][j + 1] = p2[1]; ps2 = ps2 + p2; }
            const float ps = ps2[0] + ps2[1];
            l_run = l_run * alpha + ps;
            if (!__all(alpha == 1.0f)) {
#pragma unroll
                for (int i = 0; i < 4; ++i)
#pragma unroll
                    for (int j = 0; j < 16; ++j) ot[i][j] *= alpha;
            }
            bf16x8 vfr[2][4];
#define AT_LDV(dst, s4_) do { _Pragma("unroll") for (int db = 0; db < 4; ++db) dst[db] = *(const LAS bf16x8*)(vb + voff_[s4_] + db * 4096); } while (0)
            AT_LDV(vfr[0], 0);
#pragma unroll
            for (int s4 = 0; s4 < 4; ++s4) { const int kh = s4 >> 1, sl = s4 & 1;
                if (s4 < 3) AT_LDV(vfr[(s4 + 1) & 1], s4 + 1);
                u32x4 pw; pw.x = cvt_pk_bf16(st[kh][8 * sl + 0], st[kh][8 * sl + 1]); pw.y = cvt_pk_bf16(st[kh][8 * sl + 2], st[kh][8 * sl + 3]);
                pw.z = cvt_pk_bf16(st[kh][8 * sl + 4], st[kh][8 * sl + 5]); pw.w = cvt_pk_bf16(st[kh][8 * sl + 6], st[kh][8 * sl + 7]);
                const bf16x8 pf = __builtin_bit_cast(bf16x8, pw);
#pragma unroll
                for (int db = 0; db < 4; ++db) ot[db] = __builtin_amdgcn_mfma_f32_32x32x16_bf16(vfr[s4 & 1][db], pf, ot[db], 0, 0, 0);
            }
#undef AT_LDV
            const float ub = qk_bound + cb[0];
            if (__all(ub < m_run - ATT_SKIP)) { done = true; if (lane == 0) __hip_atomic_fetch_add((LAS unsigned*)donecnt, 1u, __ATOMIC_RELAXED, __HIP_MEMORY_SCOPE_WORKGROUP); }
        }
    }
#undef AT_WAITV
    asm volatile("s_waitcnt vmcnt(0)" ::: "memory");
    const float lt = l_run + __shfl_xor(l_run, 32);
    const float inv = 1.0f / lt;
#pragma unroll
    for (int db = 0; db < 4; ++db)
#pragma unroll
        for (int g4 = 0; g4 < 4; ++g4) { const int d = db * 32 + 8 * g4 + 4 * hh;
            u32x2 o; o.x = cvt_pk_bf16(ot[db][4 * g4 + 0] * inv, ot[db][4 * g4 + 1] * inv); o.y = cvt_pk_bf16(ot[db][4 * g4 + 2] * inv, ot[db][4 * g4 + 3] * inv);
            *(u32x2*)(ob_ + (size_t)qrow * D + hd * FD + d) = o; }
    asm volatile("s_waitcnt lgkmcnt(0)" ::: "memory");
    __builtin_amdgcn_s_barrier();
    asm volatile("" ::: "memory");
}

extern __shared__ __attribute__((aligned(16))) unsigned char lds_raw[];
#ifndef ONLY_PH
#define ONLY_PH -1
#endif
#ifndef PROBE_MASK
#define PROBE_MASK 0u
#endif
#define IN(i) ((const float*)(const GAS float*)kp[i])
#define PH_BEGIN(id) if ((ONLY_PH < 0 || ONLY_PH == (id)) && ph >= lo && ph < hi) { \
    int tid = threadIdx.x; asm volatile("" : "+v"(tid)); KP kp = kp0; asm volatile("" : "+s"(kp)); \
    LAS unsigned char* lds = (LAS unsigned char*)lds_raw; \
    const int lane = tid & 63, wave = __builtin_amdgcn_readfirstlane(tid >> 6); \
    const int G = gridDim.x, bx = blockIdx.x; \
    const int gw = bx * 8 + wave, NGW = G * 8, gtid = bx * 512 + tid, GT = G * 512; \
    unsigned char* ws = (unsigned char*)(GAS unsigned char*)kp[31]; float* X = (float*)(GAS float*)kp[30]; \
    (void)lane; (void)gw; (void)NGW; (void)gtid; (void)GT; (void)X; (void)lds; \
    bf16_t* hbuf = (bf16_t*)(ws + WS_H); bf16_t* xs = (bf16_t*)(ws + WS_XS); \
    bf16_t* Rb = (bf16_t*)(ws + WS_R); bf16_t* Kb = (bf16_t*)(ws + WS_K); \
    bf16_t* part = (bf16_t*)(ws + WS_PART); float* wld = (float*)(ws + WS_WLDEC); bf16_t* Ab = (bf16_t*)(ws + WS_A); bf16_t* Gb = (bf16_t*)(ws + WS_G); \
    bf16_t* act = (bf16_t*)(ws + WS_ACT); bf16_t* yg = (bf16_t*)(ws + WS_YG); \
    bf16_t* hf = (bf16_t*)(ws + WS_HF); bf16_t* Ub = (bf16_t*)(ws + WS_U); \
    bf16_t* hq = (bf16_t*)(ws + WS_XS); bf16_t* hk = (bf16_t*)(ws + WS_XS + 32 * MiB); \
    bf16_t* Qb = (bf16_t*)(ws + WS_Q); bf16_t* KBb = (bf16_t*)(ws + WS_KB); bf16_t* VTb = (bf16_t*)(ws + WS_VT); bf16_t* Ob = (bf16_t*)(ws + WS_O); \
    float* lf = (float*)(ws + WS_LF); float* cs2 = (float*)(ws + WS_CS); \
    (void)hbuf; (void)xs; (void)Rb; (void)Kb; (void)part; (void)wld; (void)Ab; (void)Gb; (void)act; (void)yg; (void)hf; (void)Ub; (void)hq; (void)hk; (void)Qb; (void)KBb; (void)VTb; (void)Ob; (void)lf; (void)cs2; \
    for (int rp_ = 0; rp_ < ((((unsigned)PROBE_MASK >> (id)) & 1u) ? 2 : 1); ++rp_) {
#define VB_ ((bf16_t*)(ws + (layer == 0 ? WS_VF : WS_V)))
#define VFB_ ((const bf16_t*)(ws + WS_VF))
#if MK_SPLIT
#define PH_END } } ++ph;
#else
#define PH_END } if (ph + 1 < hi) xcd_barrier(bar); } ++ph;
#endif

template <int layer> __device__ __forceinline__ void layer_body(int& ph, const int lo, const int hi, const XcdBarrier& bar, const KP kp0) {
                if (layer < 2) {
            const int l = layer;
            if constexpr (layer != 0) {
            PH_BEGIN(1)
            phase_r1((const void*)hf, true, IN(1) + (size_t)layer * D, IN(4) + (size_t)l * 6 * D, hbuf, xs, gw, NGW, lane);
            PH_END
            }
            PH_BEGIN(2)
            {
                pg8::Gemm g{xs, (const bf16_t*)(ws + WS_WRKV) + (size_t)l * 3 * D * D, D, D, D, 8, (size_t)S * D};
                pg8::StaticOrder so; so.init(S / 256, 3 * D / 256, 1, G, bx);
                pg8::Epi<pg8::EPI_BF16> E{Rb, Kb, VB_, nullptr, nullptr, D, D, 0, 1.f};
                pg8::gemm_phase(lds, g, so, E, tid);
            }
            {
                pg8::Gemm g{hbuf, (const bf16_t*)(ws + WS_WLD) + (size_t)l * LORA_N * 2 * D, D, 2 * D, 1024, 1 << 20, 0};
                pg8::StaticOrder so; so.init(S / 256, LORA_N / 256, 4, G, bx);
                pg8::Epi<pg8::EPI_BF16> E{part, nullptr, nullptr, nullptr, nullptr, LORA_N, 0, (size_t)S * LORA_N, 1.f};
                pg8::gemm_phase(lds, g, so, E, tid);
            }
            PH_END
            PH_BEGIN(3)
            phase_r3(part, act, gtid, GT);
#if !RIDE
            { LAS unsigned* scr = (LAS unsigned*)(lds + wave * 16384); f32x4 cv[8];
              for (int T_ = gw; T_ < c1_conv_ntiles(l); T_ += NGW) { const ConvD d_ = c1_conv_desc(kp, l, T_); conv_issue(cv, d_.W, d_.ldw, lane, d_.smode == 3); conv_finish(cv, d_.WT, d_.ldt, d_.sc, d_.smode, scr, lane); } }
#endif
            PH_END
            PH_BEGIN(4)
            {
                const bf16_t* wlu = (const bf16_t*)(ws + WS_WLU) + (size_t)l * 4 * D * 256;
                pg8::StaticOrder so; so.init(S / 256, D / 256, 1, G, bx);
                { pg8::Gemm g{act, wlu, 256, 256, 128, 1 << 20, 0};
                  pg8::Epi<pg8::EPI_LW> E{wld, nullptr, nullptr, nullptr, IN(6) + (size_t)l * D, D, 0, 0, 1.f}; int tid2 = tid; asm volatile("" : "+v"(tid2)); pg8::gemm_phase(lds, g, so, E, tid2); }
                { pg8::Gemm g{act + (size_t)S * 256, wlu + (size_t)D * 256, 256, 256, 128, 1 << 20, 0};
                  pg8::Epi<pg8::EPI_LA> E{Ab, nullptr, nullptr, nullptr, IN(9) + (size_t)l * D, D, 0, 0, 1.f}; int tid2 = tid; asm volatile("" : "+v"(tid2)); pg8::gemm_phase(lds, g, so, E, tid2); }
                if (l == 1) { pg8::Gemm g{act + (size_t)2 * S * 256, wlu + (size_t)2 * D * 256, 256, 256, 128, 1 << 20, 0};
                  pg8::Epi<pg8::EPI_LV> E{VB_, nullptr, nullptr, VFB_, IN(12), D, 0, 0, 1.f}; int tid2 = tid; asm volatile("" : "+v"(tid2)); pg8::gemm_phase(lds, g, so, E, tid2); }
                { pg8::Gemm g{act + (size_t)3 * S * 256, wlu + (size_t)3 * D * 256, 256, 256, 256, 1 << 20, 0};
                  pg8::Epi<pg8::EPI_BF16> E{Gb, nullptr, nullptr, nullptr, nullptr, D, 0, 0, 1.f}; int tid2 = tid; asm volatile("" : "+v"(tid2)); pg8::gemm_phase(lds, g, so, E, tid2); }
            }
            PH_END
            PH_BEGIN(5)
            ck::phase_c1(Rb, Kb, VB_, wld, Ab, IN(17) + (size_t)l * D, IN(18) + (size_t)l * D, IN(19) + (size_t)l * D,
                         (bf16_t*)(ws + WS_CW), (bf16_t*)(ws + WS_CBH), (bf16_t*)(ws + WS_CR), (bf16_t*)(ws + WS_CARB), (bf16_t*)(ws + WS_CU0), (bf16_t*)(ws + WS_CKV), (bf16_t*)(ws + WS_CY0),
                         (float*)(ws + WS_CGC), (float*)(ws + WS_BS), lds, bx, G, tid, kp, l);
            PH_END
            PH_BEGIN(6)
            if (bx < RH * 4) ck::phase_c2((const bf16_t*)(ws + WS_CW), (const bf16_t*)(ws + WS_CBH), (const bf16_t*)(ws + WS_CU0), (const bf16_t*)(ws + WS_CKV), (const float*)(ws + WS_CGC),
                                          (bf16_t*)(ws + WS_CUT), (bf16_t*)(ws + WS_CS0), lds, bx, tid);
            else if (RIDE) {
                c1_conv_range(kp, l, c1_conv_split(l, G) + (bx - RH * 4) * 8 + wave, c1_conv_ntiles(l), (G - RH * 4) * 8, (LAS unsigned*)(lds + wave * 16384), lane);
            }
            PH_END
            PH_BEGIN(17)
            ck::phase_c3((const bf16_t*)(ws + WS_CS0), (const bf16_t*)(ws + WS_CUT), (const bf16_t*)(ws + WS_CR), (const bf16_t*)(ws + WS_CARB), (const bf16_t*)(ws + WS_CY0), (const float*)(ws + WS_BS),
                         VB_, Gb, IN(20) + (size_t)l * D, IN(21) + (size_t)l * D, yg, bx, G, tid);
            PH_END
            PH_BEGIN(7)
            {
                pg8::Gemm g{yg, (const bf16_t*)(ws + WS_WWO) + (size_t)l * D * D, D, D, D, 1 << 20, 0};
                pg8::StaticOrder so; so.init(S / 256, D / 256, 1, G, bx);
                pg8::Epi<pg8::EPI_RES> E{X, nullptr, nullptr, layer == 0 ? (const void*)IN(0) : (const void*)hf, nullptr, D, 0, 0, 1.f, hf, (unsigned long long*)((unsigned*)(ws + WS_CTL) + CW_SS) + layer * S, nullptr, layer == 0 ? 1 : 3};
                pg8::gemm_phase(lds, g, so, E, tid);
            }
            PH_END
        } else {
            const int j = layer - 2;
            if (j == 0) {
            PH_BEGIN(8)
            {
                phase_f0(hf, IN(1) + (size_t)layer * D, hq, IN(23), hk, IN(24), IN(25), lf, (LAS float*)lds, gw, NGW, lane, tid);
            }
            PH_END
            }
            PH_BEGIN(9)
            if (j == 0) {
                if (bx < FH) phase_cumsum(lf, cs2, bx, (LAS double*)lds, tid);
                { pg8::Gemm g{hq, (const bf16_t*)(ws + WS_WQK), D, D, D, 8, (size_t)S * D};
                  pg8::StaticOrder so; so.init(S / 256, 2 * D / 256, 1, G, bx);
                  pg8::Epi<pg8::EPI_BF16> E{Qb, KBb, nullptr, nullptr, nullptr, D, D, 0, QK_SCALE, nullptr, nullptr, nullptr, 0, (unsigned*)(ws + WS_CTL) + CW_KMAX}; pg8::gemm_phase(lds, g, so, E, tid); }
                { pg8::Gemm g{(const bf16_t*)(ws + WS_WV), hk, D, D, D, 1 << 20, 0};
                  pg8::StaticOrder so; so.init(D / 256, S / 256, 1, G, bx);
                  pg8::Epi<pg8::EPI_BF16> E{VTb, nullptr, nullptr, nullptr, nullptr, S, 0, 0, 1.f}; E.vperm = 1; pg8::gemm_phase(lds, g, so, E, tid); }
            } else {
                pg8::Gemm g{hf, (const bf16_t*)(ws + WS_WQ3), D, D, D, 1 << 20, 0};
                pg8::StaticOrder so; so.init(S / 256, D / 256, 1, G, bx);
                pg8::Epi<pg8::EPI_BF16> E{Qb, nullptr, nullptr, nullptr, nullptr, D, 0, 0, QK_SCALE, nullptr, nullptr, (const unsigned long long*)((const unsigned*)(ws + WS_CTL) + CW_SS) + 4 * S}; pg8::gemm_phase(lds, g, so, E, tid);
            }
            PH_END
            PH_BEGIN(10)
            {
                volatile LAS unsigned* dc = (volatile LAS unsigned*)(lds + MISC_OFF);
                const unsigned* kmaxw = (const unsigned*)(ws + WS_CTL) + CW_KMAX;
                for (int u = bx; u < FH * 32; u += G) { const int hd = u & 15, qb2 = u >> 4;
                    attn_unit(Qb, KBb, VTb, cs2, kmaxw, Ob, lds, dc + ((u / G) & 1), hd, qb2, tid); }
            }
            PH_END
            PH_BEGIN(11)
            {
                pg8::Gemm g{Ob, (const bf16_t*)(ws + WS_WFO) + (size_t)j * D * D, D, D, D, 1 << 20, 0};
                pg8::StaticOrder so; so.init(S / 256, D / 256, 1, G, bx);
                pg8::Epi<pg8::EPI_RES> E{X, nullptr, nullptr, hf, nullptr, D, 0, 0, 1.f, hf, (unsigned long long*)((unsigned*)(ws + WS_CTL) + CW_SS) + layer * S, nullptr, 3};
                pg8::gemm_phase(lds, g, so, E, tid);
            }
            PH_END
        }
        PH_BEGIN(13)
        {
            pg8::Gemm g{hf, (const bf16_t*)(ws + (layer < 2 ? WS_WUP01 + (size_t)layer * D * FF * 2 : (layer == 2 ? WS_WUP2 : WS_WUP3))), D, D, D, 1 << 20, 0};
            pg8::StaticOrder so; so.init(S / 256, FF / 256, 1, G, bx);
            pg8::Epi<pg8::EPI_RELU2> E{Ub, nullptr, nullptr, nullptr, nullptr, FF, 0, 0, 1.f, nullptr, nullptr, (const unsigned long long*)((const unsigned*)(ws + WS_CTL) + CW_SS) + layer * S};
            E.q8 = (F8_M3_MASK >> layer) & 1;
            pg8::gemm_phase(lds, g, so, E, tid);
        }
        PH_END
        PH_BEGIN(14)
        {
            constexpr bool f8 = (F8_M3_MASK >> layer) & 1;
            pg8::Gemm g{Ub, (const bf16_t*)(ws + (layer < 2 ? WS_WDN01 + (size_t)layer * D * FF * 2 : (layer == 2 ? WS_WDN2 : WS_WDN3))), f8 ? FF / 2 : FF, f8 ? FF / 2 : FF, f8 ? FF / 2 : FF, 1 << 20, 0};
            pg8::StaticOrder so; so.init(S / 256, D / 256, 1, G, bx);
            pg8::Epi<pg8::EPI_RES> E{X, nullptr, nullptr, hf, nullptr, D, 0, 0, 1.f, (layer < 3) ? hf : nullptr, (layer == 2) ? (unsigned long long*)((unsigned*)(ws + WS_CTL) + CW_SS) + 4 * S : nullptr, nullptr, (layer < 3) ? 3 : 2};
            if constexpr (f8) { E.wamax = (const unsigned*)(ws + WS_CTL) + CW_WAMAX + layer; pg8::gemm_phase<decltype(E), true>(lds, g, so, E, tid); }
            else pg8::gemm_phase(lds, g, so, E, tid);
        }
        PH_END
    }

__global__ void __launch_bounds__(512, 2) mega(Args args) {
    const KP kp0 = (KP)__builtin_amdgcn_kernarg_segment_ptr();
    {
        volatile LAS unsigned* MISC0 = (volatile LAS unsigned*)((LAS unsigned char*)lds_raw + MISC_OFF);
        if (threadIdx.x < 16) MISC0[threadIdx.x] = 0u;
        __syncthreads();
    }
    XcdBarrier bar; bar.bar = (unsigned*)(args.ws + WS_CTL) + CW_BAR; bar.x = 0; bar.st = (volatile LAS unsigned*)((LAS unsigned char*)lds_raw + MISC_OFF) + 8;
#if !MK_SPLIT
    bar = xcd_barrier_post((unsigned*)(args.ws + WS_CTL) + CW_BAR, (volatile LAS unsigned*)((LAS unsigned char*)lds_raw + MISC_OFF) + 8);
#endif
    const int lo = args.ph_lo, hi = args.ph_hi;
    int ph = 0;
    PH_BEGIN(0)
    {
#pragma unroll
        for (int lq = 0; lq < NLAYER; ++lq) if ((F8_M3_MASK >> lq) & 1) {
            const float* wq = IN(29) + (size_t)lq * D * FF; float am = 0.f;
            for (int idx = gtid; idx < D * FF / 32; idx += GT) { const f32x4 q4 = *(const GAS f32x4*)(wq + (size_t)idx * 32); am = fmaxf(fmaxf(am, fmaxf(fabsf(q4.x), fabsf(q4.y))), fmaxf(fabsf(q4.z), fabsf(q4.w))); }
#pragma unroll
            for (int o = 1; o < 64; o <<= 1) am = fmaxf(am, __shfl_xor(am, o));
            if (lane == 0) atomicMax((unsigned*)(ws + WS_CTL) + CW_WAMAX + lq, __builtin_bit_cast(unsigned, am));
        }
        LAS float* scr = (LAS float*)(lds + wave * 16384);
        for (int l = 0; l < 2; ++l) {
            bf16_t* wrkv = (bf16_t*)(ws + WS_WRKV) + (size_t)l * 3 * D * D;
            for (int j = 0; j < 3; ++j) conv_job(IN(5) + ((size_t)l * 3 + j) * D * D, D, D, D, 0, wrkv, D, j * D, 0, nullptr, 0, scr, lane, gw, NGW);
            bf16_t* wldn = (bf16_t*)(ws + WS_WLD) + (size_t)l * LORA_N * 2 * D;
            const float* mix = IN(4) + (size_t)l * 6 * D;
            for (int hpart = 0; hpart < 2; ++hpart) { const int sm = hpart ? 2 : 1, co = hpart ? D : 0;
                conv_job(IN(7) + (size_t)l * D * 96, 96, D, 96, 0, wldn, 2 * D, 0, co, mix + 3 * D, sm, scr, lane, gw, NGW);
                conv_job(IN(10) + (size_t)l * D * 96, 96, D, 96, 0, wldn, 2 * D, 96, co, mix + 4 * D, sm, scr, lane, gw, NGW);
                if (l == 1) conv_job(IN(13), 64, D, 64, 0, wldn, 2 * D, 192, co, mix + 2 * D, sm, scr, lane, gw, NGW);
                conv_job(IN(15) + (size_t)l * D * 256, 256, D, 256, 0, wldn, 2 * D, 256, co, mix + 5 * D, sm, scr, lane, gw, NGW);
            }
            if (l == 0) { for (int idx = gtid; idx < 64 * 2 * D / 8; idx += GT) *(u32x4*)(wldn + (size_t)192 * 2 * D + (size_t)idx * 8) = (u32x4){0u, 0u, 0u, 0u}; }
            bf16_t* wlu = (bf16_t*)(ws + WS_WLU) + (size_t)l * 4 * D * 256;
            conv_lu(IN(8) + (size_t)l * 96 * D, 96, wlu, gtid, GT);
            conv_lu(IN(11) + (size_t)l * 96 * D, 96, wlu + (size_t)D * 256, gtid, GT);
            if (l == 1) conv_lu(IN(14), 64, wlu + (size_t)2 * D * 256, gtid, GT);
            conv_lu(IN(16) + (size_t)l * 256 * D, 256, wlu + (size_t)3 * D * 256, gtid, GT);
            conv_job(IN(22) + (size_t)l * D * D, D, D, D, 0, (bf16_t*)(ws + WS_WWO) + (size_t)l * D * D, D, 0, 0, nullptr, 0, scr, lane, gw, NGW);
        }
        phase_r1((const void*)IN(0), false, IN(1), IN(4), (bf16_t*)(ws + WS_H), (bf16_t*)(ws + WS_XS), gw, NGW, lane);
    }
    PH_END

    layer_body<0>(ph, lo, hi, bar, kp0); layer_body<1>(ph, lo, hi, bar, kp0); layer_body<2>(ph, lo, hi, bar, kp0); layer_body<3>(ph, lo, hi, bar, kp0);
    static_assert(NLAYER == 4, "four layer instantiations");
    PH_BEGIN(15)
    phase_final(X, IN(3), gw, NGW, lane);
    PH_END
#undef PH_BEGIN
#undef IN
#undef PH_END
}
constexpr int N_PHASES = 1 + (9 + 10) + 6 + 5 + 1;

extern "C" void kernel_launch(void* const* d_in, const int* in_sizes, int n_in, void* d_out, int out_size, void* d_ws, size_t ws_size, hipStream_t stream) {
    static int grid = 0;
    if (grid == 0) {
        if (n_in != 30 || in_sizes[0] != S * D || out_size != S * D || ws_size < WS_END) { fprintf(stderr, "kernel_launch: unexpected shapes / workspace (n_in %d, ws %zu)\n", n_in, ws_size); grid = -1; return; }
        int dev = 0, cus = 0, per_cu = 0;
        if (hipGetDevice(&dev) != hipSuccess || hipDeviceGetAttribute(&cus, hipDeviceAttributeMultiprocessorCount, dev) != hipSuccess) { grid = -1; return; }
        if (hipFuncSetAttribute((const void*)mega, hipFuncAttributeMaxDynamicSharedMemorySize, LDS_BYTES) != hipSuccess) { fprintf(stderr, "kernel_launch: hipFuncSetAttribute failed\n"); grid = -1; return; }
        if (hipOccupancyMaxActiveBlocksPerMultiprocessor(&per_cu, (const void*)mega, 512, LDS_BYTES) != hipSuccess || per_cu < 1) { fprintf(stderr, "kernel_launch: occupancy query reports %d\n", per_cu); }
        (void)hipGetLastError();
        grid = cus;
    }
    if (grid < 0) return;
    (void)hipMemsetAsync((char*)d_ws + WS_CTL, 0, CTL_ZERO_BYTES, stream);
    Args a{};
    for (int i = 0; i < 30; ++i) a.in[i] = (const float*)d_in[i];
    a.out = (float*)d_out; a.ws = (unsigned char*)d_ws;
#if MK_SPLIT
    for (int p = 0; p < N_PHASES; ++p) { a.ph_lo = p; a.ph_hi = p + 1; hipLaunchKernelGGL(mega, dim3(grid), dim3(512), LDS_BYTES, stream, a); }
#else
    a.ph_lo = 0; a.ph_hi = N_PHASES;
    hipLaunchKernelGGL(mega, dim3(grid), dim3(512), LDS_BYTES, stream, a);
#endif
}
```
